# Optimizing an MI355X kernel written in HIP

```python
import jax
import jax.numpy as jnp
from jax import lax
import numpy as np

D_MODEL = 1024
BATCH = 8
SEQ = 4096
DEPTH = 1

HEAD_DIM = 64
SWA_HEADS = 8
SWA_KV_HEADS = 2
SWA_GROUP = SWA_HEADS // SWA_KV_HEADS
WINDOW = 128
SB_HEADS = 8
BLOCK = 128
SWA_WIDTH = SWA_HEADS * HEAD_DIM
SWA_KV_WIDTH = SWA_KV_HEADS * HEAD_DIM
SB_WIDTH = SB_HEADS * HEAD_DIM
IN_WIDTH = SWA_WIDTH + 2 * SWA_KV_WIDTH + 3 * SB_WIDTH + 2 * D_MODEL
N_EXPERTS = 32
TOP_K = 4
D_FF = D_MODEL
SWIGLU_LIMIT = 7.0
SWIGLU_ALPHA = 1.702
MOE_BLOCK = 128
NORM_EPS = 1e-5

kernel_name = "hybrid_swa_stickbreak_moe_block"


def rms_norm(x, w):
    xf = x.astype(jnp.float32)
    y = xf * lax.rsqrt(jnp.mean(xf * xf, axis=-1, keepdims=True) + NORM_EPS)
    return (y * w.astype(jnp.float32)).astype(x.dtype)


def alibi_slopes(n_heads):
    return jnp.asarray([2.0 ** (-8.0 * (i + 1) / n_heads) for i in range(n_heads)], dtype=jnp.float32)


def in_split_points():
    widths = (SWA_WIDTH, SWA_KV_WIDTH, SWA_KV_WIDTH, SB_WIDTH, SB_WIDTH, SB_WIDTH, D_MODEL, D_MODEL)
    points, acc = [], 0
    for w in widths[:-1]:
        acc += w
        points.append(acc)
    return points


def sliding_window_attention(q, k, v, q_norm_w, k_norm_w, sinks):
    B, S = q.shape[0], q.shape[1]
    nb = S // BLOCK
    q = rms_norm(q, q_norm_w)
    k = rms_norm(k, k_norm_w)
    qb = q.reshape(B, nb, BLOCK, SWA_KV_HEADS, SWA_GROUP, HEAD_DIM)

    def band(t):
        tb = t.reshape(B, nb, BLOCK, SWA_KV_HEADS, HEAD_DIM)
        prev = jnp.pad(tb[:, :-1], ((0, 0), (1, 0), (0, 0), (0, 0), (0, 0)))
        return jnp.concatenate([prev, tb], axis=2)

    kb, vb = band(k), band(v)
    scores = jnp.einsum('bnqhgd,bnkhd->bnhgqk', qb, kb).astype(jnp.float32) * (HEAD_DIM ** -0.5)
    q_pos = jnp.arange(BLOCK)[:, None] + BLOCK
    k_pos = jnp.arange(2 * BLOCK)[None, :]
    rel = q_pos - k_pos
    k_abs = jnp.arange(nb)[:, None, None] * BLOCK - BLOCK + k_pos
    valid = (rel >= 0) & (rel < WINDOW) & (k_abs >= 0)
    slopes = alibi_slopes(SWA_HEADS).reshape(SWA_KV_HEADS, SWA_GROUP)
    scores = scores - slopes[:, :, None, None] * rel.astype(jnp.float32)
    scores = jnp.where(valid[None, :, None, None], scores, -jnp.inf)
    sink = jnp.broadcast_to(sinks.astype(jnp.float32).reshape(1, 1, SWA_KV_HEADS, SWA_GROUP, 1, 1),
                            scores.shape[:-1] + (1,))
    probs = jax.nn.softmax(jnp.concatenate([scores, sink], axis=-1), axis=-1)[..., :-1]
    out = jnp.einsum('bnhgqk,bnkhd->bnqhgd', probs.astype(v.dtype), vb)
    return out.reshape(B, S, SWA_WIDTH)


def stick_breaking_attention(q, k, v):
    B, S = q.shape[0], q.shape[1]
    nb = S // BLOCK
    qb = q.reshape(B, nb, BLOCK, SB_HEADS, HEAD_DIM).transpose(1, 0, 2, 3, 4)
    k_pos = jnp.arange(S)
    scale = HEAD_DIM ** -0.5

    def one_block(args):
        q_blk, start = args
        z = jnp.einsum('bqhd,bkhd->bhqk', q_blk, k).astype(jnp.float32) * scale
        q_pos = start + jnp.arange(BLOCK)
        strict = k_pos[None, :] < q_pos[:, None]
        log_beta = jax.nn.log_sigmoid(z)
        log_keep = jnp.where(strict, jax.nn.log_sigmoid(-z), 0.0)
        between = lax.cumsum(log_keep, axis=3, reverse=True) - log_keep
        weights = jnp.where(strict, jnp.exp(log_beta + between), 0.0)
        return jnp.einsum('bhqk,bkhd->bqhd', weights.astype(v.dtype), v)

    out = lax.map(one_block, (qb, jnp.arange(nb) * BLOCK))
    return out.transpose(1, 0, 2, 3, 4).reshape(B, S, SB_WIDTH)


def moe_ffn(h, router_w, router_b, w_gate_up, b_gate_up, w_down, b_down):
    B, S, D = h.shape
    N = B * S
    xf = h.reshape(N, D)
    logits = (xf @ router_w + router_b).astype(jnp.float32)
    top_logit, top_idx = lax.top_k(logits, TOP_K)
    gate = jax.nn.softmax(top_logit, axis=-1)
    A = N * TOP_K
    flat_e = top_idx.reshape(A)
    order = jnp.argsort(flat_e)
    sorted_e = flat_e[order]
    slot_token = (order // TOP_K).astype(jnp.int32)
    slot_gate = gate.reshape(A)[order]
    counts = jnp.bincount(flat_e, length=N_EXPERTS)
    padded = (counts + MOE_BLOCK - 1) // MOE_BLOCK * MOE_BLOCK
    start = jnp.cumsum(counts) - counts
    pad_end = jnp.cumsum(padded)
    pad_start = pad_end - padded
    dest = pad_start[sorted_e] + jnp.arange(A) - start[sorted_e]
    cap = A + N_EXPERTS * MOE_BLOCK
    n_blocks = cap // MOE_BLOCK
    buf_token = jnp.zeros((cap,), jnp.int32).at[dest].set(slot_token)
    buf_gate = jnp.zeros((cap,), jnp.float32).at[dest].set(slot_gate)
    block_expert = jnp.minimum(
        jnp.searchsorted(pad_end, jnp.arange(n_blocks) * MOE_BLOCK, side='right'), N_EXPERTS - 1)
    xb = xf[buf_token].reshape(n_blocks, MOE_BLOCK, D)

    def expert_block(args):
        x_blk, e = args
        gu = x_blk @ w_gate_up[e] + b_gate_up[e]
        g = jnp.minimum(gu[:, :D_FF], SWIGLU_LIMIT)
        u = jnp.clip(gu[:, D_FF:], -SWIGLU_LIMIT, SWIGLU_LIMIT)
        act = (u + 1.0) * (g * jax.nn.sigmoid(SWIGLU_ALPHA * g))
        return act @ w_down[e] + b_down[e]

    yb = lax.map(expert_block, (xb, block_expert)).reshape(cap, D)
    out = jnp.zeros((N, D), h.dtype).at[buf_token].add(yb * buf_gate[:, None].astype(yb.dtype))
    return out.reshape(B, S, D)


def setup_inputs(seed: int = 0) -> dict:
    key = jax.random.key(seed)
    ks = jax.random.split(key, 16)
    L = DEPTH

    def nrm(k, shape, scale):
        return jax.random.normal(k, shape, jnp.float32) * scale

    return {
        "x": nrm(ks[0], (BATCH, SEQ, D_MODEL), 1.0),
        "attn_norm_w": 1.0 + nrm(ks[1], (L, D_MODEL), 0.02),
        "w_in": nrm(ks[2], (L, D_MODEL, IN_WIDTH), D_MODEL ** -0.5),
        "q_norm_w": 1.0 + nrm(ks[3], (L, HEAD_DIM), 0.02),
        "k_norm_w": 1.0 + nrm(ks[4], (L, HEAD_DIM), 0.02),
        "sinks": nrm(ks[5], (L, SWA_HEADS), 0.5),
        "w_proj_swa": nrm(ks[6], (L, SWA_WIDTH, D_MODEL), SWA_WIDTH ** -0.5),
        "w_proj_sb": nrm(ks[7], (L, SB_WIDTH, D_MODEL), SB_WIDTH ** -0.5),
        "w_out": nrm(ks[8], (L, D_MODEL, D_MODEL), D_MODEL ** -0.5),
        "ffn_norm_w": 1.0 + nrm(ks[9], (L, D_MODEL), 0.02),
        "router_w": nrm(ks[10], (L, D_MODEL, N_EXPERTS), D_MODEL ** -0.5),
        "router_b": nrm(ks[11], (L, N_EXPERTS), 0.01),
        "w_gate_up": nrm(ks[12], (L, N_EXPERTS, D_MODEL, 2 * D_FF), D_MODEL ** -0.5),
        "b_gate_up": nrm(ks[13], (L, N_EXPERTS, 2 * D_FF), 0.01),
        "w_down": nrm(ks[14], (L, N_EXPERTS, D_FF, D_MODEL), D_FF ** -0.5),
        "b_down": nrm(ks[15], (L, N_EXPERTS, D_MODEL), 0.01),
    }


def reference(x, attn_norm_w, w_in, q_norm_w, k_norm_w, sinks, w_proj_swa, w_proj_sb, w_out,
              ffn_norm_w, router_w, router_b, w_gate_up, b_gate_up, w_down, b_down):
    B, S = x.shape[0], x.shape[1]
    h = x
    for layer in range(DEPTH):
        xn = rms_norm(h, attn_norm_w[layer])
        proj = xn @ w_in[layer]
        q_a, k_a, v_a, q_b, k_b, v_b, g_a, g_b = jnp.split(proj, in_split_points(), axis=-1)
        y_a = sliding_window_attention(
            q_a.reshape(B, S, SWA_HEADS, HEAD_DIM),
            k_a.reshape(B, S, SWA_KV_HEADS, HEAD_DIM),
            v_a.reshape(B, S, SWA_KV_HEADS, HEAD_DIM),
            q_norm_w[layer], k_norm_w[layer], sinks[layer])
        y_b = stick_breaking_attention(
            q_b.reshape(B, S, SB_HEADS, HEAD_DIM),
            k_b.reshape(B, S, SB_HEADS, HEAD_DIM),
            v_b.reshape(B, S, SB_HEADS, HEAD_DIM))
        merged = (jax.nn.sigmoid(g_a) * (y_a @ w_proj_swa[layer])
                  + jax.nn.sigmoid(g_b) * (y_b @ w_proj_sb[layer]))
        h = h + merged @ w_out[layer]
        h = h + moe_ffn(rms_norm(h, ffn_norm_w[layer]), router_w[layer], router_b[layer],
                        w_gate_up[layer], b_gate_up[layer], w_down[layer], b_down[layer])
    return h
```

```cpp
#include <hip/hip_runtime.h>
#include <cstdio>
#include <cstdint>

#ifndef MK_N_LAUNCHES
#define MK_N_LAUNCHES 1
#endif
#ifndef PG8_DMA_IN_MMA
#define PG8_DMA_IN_MMA 0
#endif

namespace pg8 {
#define PG8_LAS __attribute__((address_space(3)))
__device__ __forceinline__ int lane_now() { int l; asm volatile("v_mbcnt_lo_u32_b32 %0, -1, 0\n\tv_mbcnt_hi_u32_b32 %0, -1, %0" : "=v"(l)); return l; }
typedef unsigned short bf16_t;
typedef short bf16x8 __attribute__((ext_vector_type(8)));
typedef float f32x4 __attribute__((ext_vector_type(4)));
typedef unsigned u32x4 __attribute__((ext_vector_type(4)));
constexpr int BM = 256, BK = 64, HALF = 128, HTB = HALF * BK * 2, STAGE_BYTES = 8 * HTB, NXCD = 8;

__host__ __device__ __forceinline__ int lds_byte(int r, int c) { const int st = (r >> 4) * 2 + (c >> 5), rr = r & 15, cc = c & 31, ob = rr * 64 + cc * 2; return st * 1024 + (ob ^ (((ob >> 9) & 1) << 5)); }
__host__ __device__ __forceinline__ void stage_rc(int b, int& R, int& C) { const int st = b / 1024, sb = b % 1024, swz = sb ^ (((sb >> 9) & 1) << 5); R = (st >> 1) * 16 + swz / 64; C = (st & 1) * 32 + (swz % 64) / 2; }
__host__ __device__ __forceinline__ int perm32(int rho) { const int n = rho >> 4, i = rho & 15; return 8 * (i >> 2) + 4 * n + (i & 3); }

struct Unit { int pm, pn; };
struct Gemm { const void* base; unsigned a_off, b_off; int lda; int K; };

struct StaticOrder {
    int nM, nN, nwg, G, c, base, nmine, WGM;
    __device__ void init(int M, int N, int G_, int c_, int wgm = 4) { nM = M / BM; nN = N / BM; nwg = nM * nN; G = G_; c = c_; base = 0; nmine = 0x7fffffff; WGM = wgm; }
    __device__ void init_uneven(int M, int N, int stride_, int c_, int base_, int nmine_, int wgm = 4) { nM = M / BM; nN = N / BM; nwg = nM * nN; G = stride_; c = c_; base = base_; nmine = nmine_; WGM = wgm; }
    __device__ __forceinline__ bool next(int i, Unit& u) const {
        const long L = (long)base + (long)i * G + c; if (i >= nmine || L >= nwg) return false;
        int wgid = (int)L; { const int q = nwg / NXCD, r = nwg % NXCD, xcd = wgid % NXCD, off = wgid / NXCD; wgid = (xcd < r ? xcd * (q + 1) : r * (q + 1) + (xcd - r) * q) + off; }
        const int nig = WGM * nN, gid = wgid / nig, fm = gid * WGM, gsz = (nM - fm) < WGM ? (nM - fm) : WGM;
        u.pm = fm + ((wgid % nig) % gsz); u.pn = (wgid % nig) / gsz; return true;
    }
    __device__ __forceinline__ long lin(int i) const { return (long)base + (long)i * G + c; }
    __device__ __forceinline__ unsigned a_ptr(const Gemm& g, const Unit& u) const { return g.a_off + (unsigned)u.pm * (unsigned)(BM * 2) * (unsigned)g.lda; }
    __device__ __forceinline__ unsigned b_ptr(const Gemm& g, const Unit& u) const { return g.b_off + (unsigned)u.pn * (unsigned)(BM * 2) * (unsigned)g.K; }
    __device__ __forceinline__ unsigned row_off(int, int) const { return 0u; }
};

struct GroupOrder {
    int nM, nN, nwg, G, c, WGM;
    const PG8_LAS int* tiletab;
    const PG8_LAS unsigned* rowtab;
    unsigned bstride;
    bool gather;
    __device__ void init(int nM_, int nN_, int G_, int c_, int wgm = 4) { nM = nM_; nN = nN_; nwg = nM * nN; G = G_; c = c_; WGM = wgm; }
    __device__ __forceinline__ bool next(int i, Unit& u) const {
        const long L = (long)i * G + c; if (L >= nwg) return false;
        int wgid = (int)L; { const int q = nwg / NXCD, r = nwg % NXCD, xcd = wgid % NXCD, off = wgid / NXCD; wgid = (xcd < r ? xcd * (q + 1) : r * (q + 1) + (xcd - r) * q) + off; }
        const int nig = WGM * nN, gid = wgid / nig, fm = gid * WGM, gsz = (nM - fm) < WGM ? (nM - fm) : WGM;
        u.pm = fm + ((wgid % nig) % gsz); u.pn = (wgid % nig) / gsz; return true;
    }
    __device__ __forceinline__ unsigned a_ptr(const Gemm& g, const Unit& u) const { return gather ? g.a_off : g.a_off + (unsigned)u.pm * (unsigned)(BM * 2) * (unsigned)g.lda; }
    __device__ __forceinline__ unsigned b_ptr(const Gemm& g, const Unit& u) const { const int e = __builtin_amdgcn_readfirstlane(tiletab[u.pm]) >> 16; return g.b_off + (unsigned)e * bstride + (unsigned)u.pn * (unsigned)(BM * 2) * (unsigned)g.K; }
    __device__ __forceinline__ unsigned row_off(int ui, int r) const { return rowtab[ui * 256 + r]; }
    __device__ __forceinline__ long lin(int i) const { return (long)i * G + c; }
};

__device__ __forceinline__ unsigned cvt_pk_bf16(float lo, float hi) { typedef float f2 __attribute__((ext_vector_type(2))); typedef __bf16 b2 __attribute__((ext_vector_type(2))); f2 v = {lo, hi}; b2 b = __builtin_convertvector(v, b2); return __builtin_bit_cast(unsigned, b); }
__device__ __forceinline__ float bf_lo(unsigned u) { return __uint_as_float(u << 16); }
__device__ __forceinline__ float bf_hi(unsigned u) { return __uint_as_float(u & 0xffff0000u); }
__device__ __forceinline__ float sigmoid_f(float x) { return __builtin_amdgcn_rcpf(1.0f + __builtin_amdgcn_exp2f(-1.4426950408889634f * x)); }

__device__ __forceinline__ float clamp448(float x) { return __builtin_amdgcn_fmed3f(x, -448.0f, 448.0f); }
__device__ __forceinline__ unsigned pk4_fp8(float a, float b, float c, float d) {
    int r = __builtin_amdgcn_cvt_pk_fp8_f32(clamp448(a), clamp448(b), 0, false); r = __builtin_amdgcn_cvt_pk_fp8_f32(clamp448(c), clamp448(d), r, true); return (unsigned)r; }
typedef float f32x2 __attribute__((ext_vector_type(2)));
__device__ __forceinline__ unsigned pk4_fp8_nc(f32x2 a, f32x2 b) { int r = __builtin_amdgcn_cvt_pk_fp8_f32(a.x, a.y, 0, false); r = __builtin_amdgcn_cvt_pk_fp8_f32(b.x, b.y, r, true); return (unsigned)r; }
__device__ __forceinline__ f32x4 sigmoid4_scaled(f32x4 a, float ks) {
    constexpr float AMAX = 30.0f * 1.4426950408889634f; f32x4 s;
#pragma unroll
    for (int q = 0; q < 4; ++q) s[q] = __builtin_amdgcn_rcpf(1.0f + __builtin_amdgcn_exp2f(fminf(a[q] * ks, AMAX)));
    return s;
}
constexpr unsigned EPIMETA = 152576u, EPIMETA_IMG = 3072u;
__device__ __forceinline__ void meta_dma(const void* src, unsigned byte_off, unsigned lds_addr, int lane) {
    const __amdgpu_buffer_rsrc_t r = __builtin_amdgcn_make_buffer_rsrc((void*)src, 0, 0x7fffffff, 0x00020000);
    __builtin_amdgcn_raw_ptr_buffer_load_lds(r, (PG8_LAS unsigned*)lds_addr, 4, lane * 4, (int)byte_off, 0, 0);
}
struct EpiBf16 {
    static constexpr bool PERM = true; static constexpr bool META = false;
    bf16_t* O; int ldc; float scale; int sig;
    static constexpr unsigned RING_END = 131072u;
    __device__ __forceinline__ void half(int ai, const f32x4 (&acc)[2][2][4][2], const Unit& u, int wr, int wc, int fr, int fq) const {
        PG8_LAS unsigned char* t = (PG8_LAS unsigned char*)(RING_END + (unsigned)(wr * 4 + wc) * 2048u); const int lane = fq * 16 + fr;
#pragma unroll
        for (int m = 0; m < 4; ++m) {
#pragma unroll
            for (int bj = 0; bj < 2; ++bj) { f32x4 v0 = acc[ai][bj][m][0] * scale, v1 = acc[ai][bj][m][1] * scale;
                if (sig) { const float ks = -1.4426950408889634f * scale; v0 = sigmoid4_scaled(acc[ai][bj][m][0], ks); v1 = sigmoid4_scaled(acc[ai][bj][m][1], ks); }
                u32x4 w; w.x = cvt_pk_bf16(v0[0], v0[1]); w.y = cvt_pk_bf16(v0[2], v0[3]); w.z = cvt_pk_bf16(v1[0], v1[1]); w.w = cvt_pk_bf16(v1[2], v1[3]);
                *(PG8_LAS u32x4*)(t + fr * 128 + bj * 64 + fq * 16) = w; }
            asm volatile("" ::: "memory");
            bf16_t* base = O + (size_t)(u.pm * BM + ai * HALF + wr * 64 + m * 16) * ldc + u.pn * BM + wc * 64;
#pragma unroll
            for (int p = 0; p < 2; ++p) { const int row = 8 * p + (lane >> 3); const u32x4 w = *(const PG8_LAS u32x4*)(t + row * 128 + (lane & 7) * 16);
                __builtin_nontemporal_store(w, (u32x4*)(base + (size_t)row * ldc + 8 * (lane & 7))); }
            asm volatile("" ::: "memory");
        }
    }
    __device__ __forceinline__ void operator()(const f32x4 (&acc)[2][2][4][2], const Unit& u, int wr, int wc, int fr, int fq) const { half(0, acc, u, wr, wc, fr, fq); half(1, acc, u, wr, wc, fr, fq); }
};
struct EpiBf16D {
    static constexpr bool PERM = true; static constexpr bool META = false;
    bf16_t* O; int ldc;
    __device__ __forceinline__ void operator()(const f32x4 (&acc)[2][2][4][2], const Unit& u, int wr, int wc, int fr, int fq) const {
        const int row0 = u.pm * BM + wr * 64 + fr, col0 = u.pn * BM + wc * 32 + 8 * fq;
#pragma unroll
        for (int ai = 0; ai < 2; ++ai)
#pragma unroll
            for (int m = 0; m < 4; ++m) { bf16_t* rowp = O + (size_t)(row0 + ai * HALF + m * 16) * ldc + col0;
#pragma unroll
                for (int bj = 0; bj < 2; ++bj) { const f32x4 v0 = acc[ai][bj][m][0], v1 = acc[ai][bj][m][1];
                    u32x4 w; w.x = cvt_pk_bf16(v0[0], v0[1]); w.y = cvt_pk_bf16(v0[2], v0[3]); w.z = cvt_pk_bf16(v1[0], v1[1]); w.w = cvt_pk_bf16(v1[2], v1[3]);
                    *(u32x4*)(rowp + bj * HALF) = w; } }
    }
};
__device__ __forceinline__ float gate_e(float g) { return __builtin_amdgcn_exp2f(-1.4426950408889634f * g); }
struct HookGateRatio {
    static constexpr bool ENABLED = true;
    const bf16_t* Ga; const bf16_t* Gb; int ldg;
    __device__ __forceinline__ void operator()(f32x4 (&acc)[2][2][4][2], const Unit& u, int wr, int wc, int fr, int fq) const {
        const int row0 = u.pm * BM + wr * 64 + fr, col0 = u.pn * BM + wc * 32 + 8 * fq;
#pragma unroll
        for (int ai = 0; ai < 2; ++ai)
#pragma unroll
            for (int m = 0; m < 4; ++m) { const size_t row = (size_t)(row0 + ai * HALF + m * 16);
#pragma unroll
                for (int bj = 0; bj < 2; ++bj) { const u32x4 ga = *(const u32x4*)(Ga + row * ldg + col0 + bj * HALF), gb = *(const u32x4*)(Gb + row * ldg + col0 + bj * HALF);
#pragma unroll
                    for (int q = 0; q < 4; ++q) { const float r0 = bf_lo(ga[q]) * __builtin_amdgcn_rcpf(bf_lo(gb[q])), r1 = bf_hi(ga[q]) * __builtin_amdgcn_rcpf(bf_hi(gb[q]));
                        acc[ai][bj][m][q >> 1][2 * (q & 1)] *= r0; acc[ai][bj][m][q >> 1][2 * (q & 1) + 1] *= r1; } } }
    }
};
struct EpiGateFinal {
    static constexpr bool PERM = true; static constexpr bool META = false;
    bf16_t* O; int ldc; const bf16_t* Gb; int ldg;
    __device__ __forceinline__ void operator()(const f32x4 (&acc)[2][2][4][2], const Unit& u, int wr, int wc, int fr, int fq) const {
        const int row0 = u.pm * BM + wr * 64 + fr, col0 = u.pn * BM + wc * 32 + 8 * fq;
#pragma unroll
        for (int ai = 0; ai < 2; ++ai)
#pragma unroll
            for (int m = 0; m < 4; ++m) { const size_t row = (size_t)(row0 + ai * HALF + m * 16);
#pragma unroll
                for (int bj = 0; bj < 2; ++bj) { const u32x4 gb = *(const u32x4*)(Gb + row * ldg + col0 + bj * HALF);
                    float r[8];
#pragma unroll
                    for (int q = 0; q < 4; ++q) { r[2 * q] = acc[ai][bj][m][q >> 1][2 * (q & 1)] * bf_lo(gb[q]); r[2 * q + 1] = acc[ai][bj][m][q >> 1][2 * (q & 1) + 1] * bf_hi(gb[q]); }
                    u32x4 w; w.x = cvt_pk_bf16(r[0], r[1]); w.y = cvt_pk_bf16(r[2], r[3]); w.z = cvt_pk_bf16(r[4], r[5]); w.w = cvt_pk_bf16(r[6], r[7]);
                    *(u32x4*)(O + row * ldc + col0 + bj * HALF) = w; } }
    }
};
struct EpiResF32 {
    static constexpr bool PERM = false; static constexpr bool META = false;
    const float* base; float* out; int ldc;
    __device__ __forceinline__ void operator()(const f32x4 (&acc)[2][2][4][2], const Unit& u, int wr, int wc, int fr, int fq) const {
        const int col0 = u.pn * BM + wc * 32 + 4 * fq;
        f32x4 b0[8], b1[8];
#define ERF_OFF(ch, t) ((size_t)(u.pm * BM + ((ch) >> 1) * HALF + wr * 64 + (2 * ((ch) & 1) + ((t) >> 2)) * 16 + fr) * ldc + col0 + (((t) >> 1) & 1) * HALF + ((t) & 1) * 16)
#define ERF_LOAD(B, ch) do { _Pragma("unroll") for (int t = 0; t < 8; ++t) B[t] = *(const f32x4*)(base + ERF_OFF(ch, t)); } while (0)
#define ERF_STORE(B, ch) do { _Pragma("unroll") for (int t = 0; t < 8; ++t) *(f32x4*)(out + ERF_OFF(ch, t)) = B[t] + acc[(ch) >> 1][((t) >> 1) & 1][2 * ((ch) & 1) + ((t) >> 2)][(t) & 1]; } while (0)
        ERF_LOAD(b0, 0); ERF_LOAD(b1, 1); ERF_STORE(b0, 0); ERF_LOAD(b0, 2); ERF_STORE(b1, 1); ERF_LOAD(b1, 3); ERF_STORE(b0, 2); ERF_STORE(b1, 3);
#undef ERF_OFF
#undef ERF_LOAD
#undef ERF_STORE
    }
};
struct EpiSwiglu {
    static constexpr bool PERM = true; static constexpr bool META = true;
    unsigned char* ACT; const float* bgu; const float* rs_list; const PG8_LAS int* tiletab; const PG8_LAS int* cnt;
    __device__ __forceinline__ void meta_issue(const Unit& u, int buf, int wid, int lane) const {
        const int tt = __builtin_amdgcn_readfirstlane(tiletab[u.pm]), e = tt >> 16, lt = tt & 0xffff; const unsigned dst = EPIMETA + (unsigned)buf * EPIMETA_IMG + (unsigned)wid * 256u;
        if (wid < 4) meta_dma(rs_list, (unsigned)(e * 32768 + lt * 256 + wid * 64) * 4u, dst, lane);
        else meta_dma(bgu, (unsigned)(e * 2048 + (wid >> 1 & 1) * 1024 + u.pn * HALF + (wid & 1) * 64) * 4u, dst, lane);
    }
    __device__ __forceinline__ void run(const f32x4 (&acc)[2][2][4][2], const Unit& u, int wr, int wc, int fr, int fq, int buf) const {
        const int tt = __builtin_amdgcn_readfirstlane(tiletab[u.pm]), e = tt >> 16, lt = tt & 0xffff, ce = __builtin_amdgcn_readfirstlane(cnt[e]);
        const PG8_LAS float* mf = (const PG8_LAS float*)(EPIMETA + (unsigned)buf * EPIMETA_IMG);
        const PG8_LAS float* bg = mf + 256 + wc * 32 + 8 * fq;
        const f32x4 bg0 = *(const PG8_LAS f32x4*)bg, bg1 = *(const PG8_LAS f32x4*)(bg + 4), bu0 = *(const PG8_LAS f32x4*)(bg + 128), bu1 = *(const PG8_LAS f32x4*)(bg + 132);
        const int lr0 = lt * 256 + wr * 64 + fr;
        float rsv[2][4];
#pragma unroll
        for (int ai = 0; ai < 2; ++ai)
#pragma unroll
            for (int m = 0; m < 4; ++m) { const int o = ai * HALF + m * 16; const float v = mf[wr * 64 + fr + o]; rsv[ai][m] = (lr0 + o < ce) ? v * 0.03125f : 0.f; }
        constexpr float KE = -1.702f * 1.4426950408889634f, IKE = 1.0f / KE;
        float bgK[8], buI[8];
#pragma unroll
        for (int q = 0; q < 4; ++q) { bgK[q] = bg0[q] * KE; bgK[4 + q] = bg1[q] * KE; buI[q] = (bu0[q] + 1.0f) * IKE; buI[4 + q] = (bu1[q] + 1.0f) * IKE; }
#pragma unroll
        for (int ai = 0; ai < 2; ++ai)
#pragma unroll
            for (int m = 0; m < 4; ++m) { const int rl = ai * HALF + wr * 64 + m * 16 + fr;
                const float rsK = rsv[ai][m] * KE, rsI = rsv[ai][m] * IKE;
                float r[8];
#pragma unroll
                for (int n = 0; n < 2; ++n)
#pragma unroll
                    for (int q = 0; q < 4; ++q) { float h = __builtin_fmaf(acc[ai][0][m][n][q], rsK, bgK[n * 4 + q]), v = __builtin_fmaf(acc[ai][1][m][n][q], rsI, buI[n * 4 + q]);
                        h = fmaxf(h, 7.0f * KE); v = __builtin_amdgcn_fmed3f(v, 8.0f * IKE, -6.0f * IKE);
                        const float rc = __builtin_amdgcn_rcpf(1.0f + __builtin_amdgcn_exp2f(h));
                        r[n * 4 + q] = (h * v) * rc; }
                typedef unsigned u32x2_t __attribute__((ext_vector_type(2)));
                u32x2_t w; w.x = pk4_fp8_nc((f32x2){r[0], r[1]}, (f32x2){r[2], r[3]}); w.y = pk4_fp8_nc((f32x2){r[4], r[5]}, (f32x2){r[6], r[7]});
                *(u32x2_t*)(ACT + (size_t)(u.pm * 16 + ai * 8 + wr * 4 + m) * 16384 + (u.pn * 4 + wc) * 512 + fr * 32 + fq * 8) = w; }
    }
};
struct EpiDown {
    static constexpr bool PERM = true; static constexpr bool META = true;
    unsigned char* Y; const float* bd; const int* aid_list; const float* gate_list; const PG8_LAS int* tiletab; const PG8_LAS int* cnt;
    __device__ __forceinline__ void meta_issue(const Unit& u, int buf, int wid, int lane) const {
        const int tt = __builtin_amdgcn_readfirstlane(tiletab[u.pm]), e = tt >> 16, lt = tt & 0xffff; const unsigned dst = EPIMETA + (unsigned)buf * EPIMETA_IMG + (unsigned)wid * 256u;
        if (wid < 4) { meta_dma(aid_list, (unsigned)(e * 32768 + lt * 256 + wid * 64) * 4u, dst, lane); meta_dma(bd, (unsigned)(e * 1024 + u.pn * BM + wid * 64) * 4u, dst + 2048u, lane); }
        else meta_dma(gate_list, (unsigned)(e * 32768 + lt * 256 + (wid - 4) * 64) * 4u, dst, lane);
    }
    __device__ __forceinline__ void run(const f32x4 (&acc)[2][2][4][2], const Unit& u, int wr, int wc, int fr, int fq, int buf) const {
        const int tt = __builtin_amdgcn_readfirstlane(tiletab[u.pm]), e = tt >> 16, lt = tt & 0xffff, ce = __builtin_amdgcn_readfirstlane(cnt[e]);
        const int c0 = u.pn * BM + wc * 64 + 16 * fq; const int nv = ce - lt * 256;
        const PG8_LAS float* mf = (const PG8_LAS float*)(EPIMETA + (unsigned)buf * EPIMETA_IMG); const PG8_LAS float* bdp = mf + 512 + wc * 64 + 16 * fq;
        const f32x4 b00 = *(const PG8_LAS f32x4*)(bdp), b01 = *(const PG8_LAS f32x4*)(bdp + 4), b10 = *(const PG8_LAS f32x4*)(bdp + 8), b11 = *(const PG8_LAS f32x4*)(bdp + 12);
        unsigned aidv[2][4]; float gtv[2][4];
#pragma unroll
        for (int ai = 0; ai < 2; ++ai)
#pragma unroll
            for (int m = 0; m < 4; ++m) { const int rl = ai * HALF + wr * 64 + m * 16 + fr; const unsigned a_ = __float_as_uint(mf[rl]); const float g_ = mf[256 + rl]; const bool ok = rl < nv; aidv[ai][m] = ok ? a_ : 0u; gtv[ai][m] = ok ? g_ : 0.f; }
#pragma unroll
        for (int ai = 0; ai < 2; ++ai)
#pragma unroll
            for (int m = 0; m < 4; ++m) { const int rl = ai * HALF + wr * 64 + m * 16 + fr;
                if (rl < nv) { const float gt = gtv[ai][m];
                    f32x4 v0, v1, v2, v3;
#pragma unroll
                    for (int q = 0; q < 4; ++q) { v0[q] = __builtin_fmaf(acc[ai][0][m][0][q], 0.03125f, b00[q]) * gt; v1[q] = __builtin_fmaf(acc[ai][0][m][1][q], 0.03125f, b01[q]) * gt;
                        v2[q] = __builtin_fmaf(acc[ai][1][m][0][q], 0.03125f, b10[q]) * gt; v3[q] = __builtin_fmaf(acc[ai][1][m][1][q], 0.03125f, b11[q]) * gt; }
                    u32x4 w; w.x = pk4_fp8(v0[0], v0[1], v0[2], v0[3]); w.y = pk4_fp8(v1[0], v1[1], v1[2], v1[3]); w.z = pk4_fp8(v2[0], v2[1], v2[2], v2[3]); w.w = pk4_fp8(v3[0], v3[1], v3[2], v3[3]);
                    *(u32x4*)(Y + aidv[ai][m] * 1024u + (unsigned)c0) = w; } }
    }
};

constexpr int WD_HALF_ITEMS = 32 * 16 * 32;
__device__ __forceinline__ void wd_half_load(f32x4 (&v)[8], const float* wd, int item, int lane) {
    const int e = item >> 9, q = item & 511, kb = q >> 5, nb = q & 31, g = lane >> 3, c = lane & 7;
    const float* W = wd + (size_t)e * 1024 * 1024 + (size_t)(64 * kb + 8 * g) * 1024 + 32 * nb + 4 * c;
#pragma unroll
    for (int i = 0; i < 8; ++i) v[i] = __builtin_nontemporal_load((const f32x4*)(W + (size_t)i * 1024));
}
__device__ __forceinline__ void wd_half_store(const f32x4 (&v)[8], unsigned char* WD8, int item, int lane) {
    typedef unsigned u32x2_t __attribute__((ext_vector_type(2)));
    const int e = item >> 9, q = item & 511, kb = q >> 5, nb = q & 31, g = lane >> 3, c = lane & 7;
#pragma unroll
    for (int j = 0; j < 4; ++j) { u32x2_t o;
        o.x = pk4_fp8(v[0][j] * 32.0f, v[1][j] * 32.0f, v[2][j] * 32.0f, v[3][j] * 32.0f); o.y = pk4_fp8(v[4][j] * 32.0f, v[5][j] * 32.0f, v[6][j] * 32.0f, v[7][j] * 32.0f);
        const int nn = 32 * nb + 4 * c + j, n = nn & 255, drow = (nn & ~255) + 128 * ((n >> 3) & 1) + 32 * (n >> 6) + 8 * ((n >> 4) & 3) + (n & 7);
        __builtin_nontemporal_store(o, (u32x2_t*)(WD8 + (size_t)e * 1024 * 1024 + (size_t)drow * 1024 + 64 * kb + 8 * g)); }
}
struct NoRider { static constexpr bool ENABLED = false; };
struct WdRider { static constexpr bool ENABLED = true; const float* wd; unsigned char* WD8; int slot_base; };
typedef int v4i_t __attribute__((ext_vector_type(4)));
typedef int v8i_t __attribute__((ext_vector_type(8)));
constexpr int FP8_SCALE_W = 0x7A7A7A7A;
constexpr int FP8_SCALE_A = 0x7F7F7F7F;
struct NoHook { static constexpr bool ENABLED = false; __device__ __forceinline__ void operator()(f32x4 (&)[2][2][4][2], const Unit&, int, int, int, int) const {} };
template <class Epi, class Sched, bool ALIGN_EPI, bool GATHER, bool FP8 = false, class Hook = NoHook, class Rider = NoRider, bool ABLK = false>
__device__ __forceinline__ void gemm_phase(PG8_LAS unsigned char* lds, const Gemm g, const Sched& S, const Epi& E, int wave_id, const Hook& H = Hook(), const Rider& R = Rider()) {
    const int lane = lane_now(), wid = wave_id, tid = wid * 64 + lane, wr = wid >> 2, wc = wid & 3, fr = lane & 15, fq = lane >> 4;
    const int K = g.K, nt = K / BK, lda = g.lda;
    unsigned voffB[2];
#pragma unroll
    for (int i = 0; i < 2; ++i) { int R, C; stage_rc(tid * 16 + i * 8192, R, C); const int Rb = Epi::PERM ? ((R & ~31) + perm32(R & 31)) : R;
        voffB[i] = (unsigned)(Rb * K + C) * 2u; }
#define PG8_RA(i) ({ int R_, C_; stage_rc(tid * 16 + (i) * 8192, R_, C_); R_; })
#define PG8_CA(i) ({ int R_, C_; stage_rc(tid * 16 + (i) * 8192, R_, C_); C_; })
    const __amdgpu_buffer_rsrc_t rsrc = __builtin_amdgcn_make_buffer_rsrc((void*)g.base, 0, 0x7fffffff, 0x00020000);
    const unsigned kstep = (unsigned)(BK * 2), kstepA = ABLK ? 2048u : kstep;
    const unsigned hstepB = (unsigned)(HALF * 2) * (unsigned)K;
    const unsigned ldsw = (unsigned)wid * 1024u;
    const int aoff = lds_byte(wr * 64 + fr, fq * 8), boff = lds_byte(wc * 32 + fr, fq * 8);
#define PG8_SA(b, h) (((b) * 2 + (h)) * HTB)
#define PG8_SB(b, h) ((4 + (b) * 2 + (h)) * HTB)
#define PG8_STAGE(bufoff, gbase, voff) do { _Pragma("unroll") for (int _i = 0; _i < 2; ++_i) \
        __builtin_amdgcn_raw_ptr_buffer_load_lds(rsrc, (PG8_LAS unsigned*)(lds + (bufoff) + ldsw + _i * 8192), 16, (int)(voff)[_i], (int)(gbase), 0, 0); } while (0)
#define PG8_LDA(dst, b, h) do { _Pragma("unroll") for (int m = 0; m < 4; ++m) { if constexpr (FP8) { const v4i_t lo_ = *(const PG8_LAS v4i_t*)(lds + PG8_SA(b, h) + aoff + m * 2048), hi_ = *(const PG8_LAS v4i_t*)(lds + PG8_SA(b, h) + aoff + m * 2048 + 1024); \
        dst##8[m] = __builtin_shufflevector(lo_, hi_, 0, 1, 2, 3, 4, 5, 6, 7); } else { _Pragma("unroll") for (int k = 0; k < 2; ++k) dst[m][k] = *(const PG8_LAS bf16x8*)(lds + PG8_SA(b, h) + aoff + m * 2048 + k * 1024); } } } while (0)
#define PG8_LDB(dst, b, h) do { _Pragma("unroll") for (int n = 0; n < 2; ++n) { if constexpr (FP8) { const v4i_t lo_ = *(const PG8_LAS v4i_t*)(lds + PG8_SB(b, h) + boff + n * 2048), hi_ = *(const PG8_LAS v4i_t*)(lds + PG8_SB(b, h) + boff + n * 2048 + 1024); \
        dst##8[n] = __builtin_shufflevector(lo_, hi_, 0, 1, 2, 3, 4, 5, 6, 7); } else { _Pragma("unroll") for (int k = 0; k < 2; ++k) dst[n][k] = *(const PG8_LAS bf16x8*)(lds + PG8_SB(b, h) + boff + n * 2048 + k * 1024); } } } while (0)
#define PG8_MMA(ai, bj, At, Bt) do { \
        if constexpr (FP8) { _Pragma("unroll") for (int m = 0; m < 4; ++m) _Pragma("unroll") for (int n = 0; n < 2; ++n) { \
            asm volatile("v_mfma_f32_16x16x128_f8f6f4 %0, %1, %2, %0" : "+v"(acc[ai][bj][m][n]) : "v"(Bt##8[n]), "v"(At##8[m])); } } \
        else { _Pragma("unroll") for (int m = 0; m < 4; ++m) _Pragma("unroll") for (int n = 0; n < 2; ++n) _Pragma("unroll") for (int k = 0; k < 2; ++k) \
            asm volatile("v_mfma_f32_16x16x32_bf16 %0, %1, %2, %0" : "+v"(acc[ai][bj][m][n]) : "v"(Bt[n][k]), "v"(At[m][k])); } \
        } while (0)
#define PG8_WAIT_V(n) asm volatile("s_waitcnt vmcnt(" #n ")" ::: "memory")
#define PG8_WAIT_L(n) asm volatile("s_waitcnt lgkmcnt(" #n ")" ::: "memory")
#define PG8_BAR __builtin_amdgcn_s_barrier()
#define PG8_SCHED __builtin_amdgcn_sched_barrier(0)
    Unit cur, nxt; int ui = 0;
    if (!S.next(0, cur)) return;
    unsigned cvA[2][2];
    if constexpr (GATHER) {
#pragma unroll
        for (int h = 0; h < 2; ++h)
#pragma unroll
            for (int i = 0; i < 2; ++i) cvA[h][i] = S.row_off(0, h * HALF + PG8_RA(i)) + (unsigned)PG8_CA(i) * 2u;
    } else {
#pragma unroll
        for (int i = 0; i < 2; ++i) { const int R_ = PG8_RA(i), cb_ = PG8_CA(i) * 2;
            cvA[0][i] = ABLK ? (unsigned)((R_ >> 4) * 32 * lda + (cb_ >> 5) * 512 + (R_ & 15) * 32 + (cb_ & 31)) : (unsigned)(R_ * lda + PG8_CA(i)) * 2u; cvA[1][i] = cvA[0][i]; }
    }
    const unsigned hstepA = GATHER ? 0u : (unsigned)(HALF * 2) * (unsigned)lda;
    f32x4 acc[2][2][4][2];
#pragma unroll
    for (int a = 0; a < 2; ++a)
#pragma unroll
        for (int b = 0; b < 2; ++b)
#pragma unroll
            for (int m = 0; m < 4; ++m)
#pragma unroll
                for (int n = 0; n < 2; ++n) acc[a][b][m][n] = (f32x4){0.f, 0.f, 0.f, 0.f};
    bf16x8 At[4][2], B0[2][2], B1[2][2]; v8i_t At8[4], B08[2], B18[2];
    unsigned cA = S.a_ptr(g, cur), cB = S.b_ptr(g, cur);
    if constexpr (Epi::META) E.meta_issue(cur, 0, wid, lane);
    PG8_STAGE(PG8_SB(0, 0), cB, voffB); PG8_STAGE(PG8_SB(0, 1), cB + hstepB, voffB); PG8_STAGE(PG8_SA(0, 0), cA, cvA[0]); PG8_STAGE(PG8_SA(0, 1), cA + hstepA, cvA[1]);
    if (wr == 1) PG8_BAR;
    PG8_WAIT_V(2); PG8_BAR;
    PG8_STAGE(PG8_SB(1, 0), cB + kstep, voffB); PG8_STAGE(PG8_SA(1, 0), cA + kstepA, cvA[0]); PG8_STAGE(PG8_SB(1, 1), cB + hstepB + kstep, voffB);
    PG8_WAIT_V(6); PG8_BAR;
    for (;;) {
        const bool has_next = S.next(ui + 1, nxt);
        const unsigned nA = has_next ? S.a_ptr(g, nxt) : cA, nB = has_next ? S.b_ptr(g, nxt) : cB;
#pragma nounroll
        for (int t = 0; t < nt; t += 2) {
            const bool last = (t == nt - 2);
            if constexpr (Hook::ENABLED) { if (t == (nt >> 1)) { asm volatile("s_nop 15\n\ts_nop 15" ::: "memory"); H(acc, cur, wr, wc, fr, fq); } }
            const unsigned tk = (unsigned)t * kstep, tkA = (unsigned)t * kstepA;
            const unsigned a1 = cA + tkA + kstepA;
            const unsigned a2 = last ? nA : cA + tkA + 2 * kstepA, b2 = last ? nB : cB + tk + 2 * kstep;
            const unsigned a3 = a2 + kstepA, b3 = b2 + kstep;
            if constexpr (GATHER) { if (last && has_next) {
#pragma unroll
                    for (int i = 0; i < 2; ++i) cvA[0][i] = S.row_off(ui + 1, PG8_RA(i)) + (unsigned)PG8_CA(i) * 2u; } }
            unsigned w0[2], w1[2];
#pragma unroll
            for (int i = 0; i < 2; ++i) { w0[i] = cvA[0][i]; w1[i] = cvA[1][i]; }
#if PG8_DMA_IN_MMA
            PG8_LDB(B0, 0, 0); PG8_LDB(B1, 0, 1); PG8_SCHED; PG8_LDA(At, 0, 0);
            PG8_WAIT_V(6); PG8_WAIT_L(0); PG8_BAR; PG8_MMA(0, 0, At, B0); PG8_STAGE(PG8_SA(1, 1), a1 + hstepA, cvA[1]); PG8_MMA(0, 1, At, B1); PG8_BAR; PG8_SCHED;
            if constexpr (GATHER) { if (last && has_next) {
#pragma unroll
                    for (int i = 0; i < 2; ++i) { cvA[1][i] = S.row_off(ui + 1, HALF + PG8_RA(i)) + (unsigned)PG8_CA(i) * 2u; w1[i] = cvA[1][i]; } } }
            PG8_LDA(At, 0, 1);
            PG8_WAIT_V(2); PG8_WAIT_L(0); PG8_BAR; PG8_MMA(1, 0, At, B0); PG8_STAGE(PG8_SB(0, 0), b2, voffB); PG8_STAGE(PG8_SB(0, 1), b2 + hstepB, voffB); PG8_MMA(1, 1, At, B1); PG8_STAGE(PG8_SA(0, 0), a2, w0); PG8_BAR; PG8_SCHED;
            PG8_LDB(B0, 1, 0); PG8_LDB(B1, 1, 1); PG8_SCHED; PG8_LDA(At, 1, 0);
            PG8_WAIT_V(6); PG8_WAIT_L(0); PG8_BAR; PG8_MMA(0, 0, At, B0); PG8_STAGE(PG8_SA(0, 1), a2 + hstepA, w1); PG8_MMA(0, 1, At, B1); PG8_BAR; PG8_SCHED;
            PG8_LDA(At, 1, 1);
            PG8_WAIT_V(2); PG8_WAIT_L(0); PG8_BAR; PG8_MMA(1, 0, At, B0); PG8_STAGE(PG8_SB(1, 0), b3, voffB); PG8_STAGE(PG8_SB(1, 1), b3 + hstepB, voffB); PG8_MMA(1, 1, At, B1); PG8_STAGE(PG8_SA(1, 0), a3, w0); PG8_BAR; PG8_SCHED;
#else
            PG8_LDB(B0, 0, 0); PG8_LDB(B1, 0, 1); PG8_SCHED; PG8_LDA(At, 0, 0); PG8_STAGE(PG8_SA(1, 1), a1 + hstepA, cvA[1]);
            PG8_WAIT_V(8); PG8_WAIT_L(0); PG8_BAR; PG8_MMA(0, 0, At, B0); PG8_MMA(0, 1, At, B1); PG8_BAR; PG8_SCHED;
            if constexpr (GATHER) { if (last && has_next) {
#pragma unroll
                    for (int i = 0; i < 2; ++i) { cvA[1][i] = S.row_off(ui + 1, HALF + PG8_RA(i)) + (unsigned)PG8_CA(i) * 2u; w1[i] = cvA[1][i]; } } }
            if constexpr (Epi::META) { if (t == 0 && has_next) E.meta_issue(nxt, (ui + 1) & 1, wid, lane); }
            PG8_LDA(At, 0, 1); PG8_STAGE(PG8_SB(0, 0), b2, voffB); PG8_STAGE(PG8_SB(0, 1), b2 + hstepB, voffB); PG8_STAGE(PG8_SA(0, 0), a2, w0);
            PG8_WAIT_V(8); PG8_WAIT_L(0); PG8_BAR; PG8_MMA(1, 0, At, B0); PG8_MMA(1, 1, At, B1); PG8_BAR; PG8_SCHED;
            PG8_LDB(B0, 1, 0); PG8_LDB(B1, 1, 1); PG8_SCHED; PG8_LDA(At, 1, 0); PG8_STAGE(PG8_SA(0, 1), a2 + hstepA, w1);
            PG8_WAIT_V(8); PG8_WAIT_L(0); PG8_BAR; PG8_MMA(0, 0, At, B0); PG8_MMA(0, 1, At, B1); PG8_BAR; PG8_SCHED;
            PG8_LDA(At, 1, 1); PG8_STAGE(PG8_SB(1, 0), b3, voffB); PG8_STAGE(PG8_SB(1, 1), b3 + hstepB, voffB); PG8_STAGE(PG8_SA(1, 0), a3, w0);
            PG8_WAIT_V(8); PG8_WAIT_L(0); PG8_BAR; PG8_MMA(1, 0, At, B0); PG8_MMA(1, 1, At, B1); PG8_BAR; PG8_SCHED;
#endif
        }
        if constexpr (ALIGN_EPI) { if (wr == 0) PG8_BAR; }
        asm volatile("s_nop 15\n\ts_nop 15" ::: "memory");
        if constexpr (Rider::ENABLED) {
            const int item_ = (R.slot_base + (int)S.lin(ui)) * 8 + wid; f32x4 rv_[8]; const bool ok_ = item_ < WD_HALF_ITEMS;
            if (ok_) wd_half_load(rv_, R.wd, item_, lane);
            E(acc, cur, wr, wc, fr, fq);
            if (ok_) wd_half_store(rv_, R.WD8, item_, lane);
        } else if constexpr (Epi::META) E.run(acc, cur, wr, wc, fr, fq, ui & 1);
        else E(acc, cur, wr, wc, fr, fq);
        if (!has_next) break;
#pragma unroll
        for (int a = 0; a < 2; ++a)
#pragma unroll
            for (int b = 0; b < 2; ++b)
#pragma unroll
                for (int m = 0; m < 4; ++m)
#pragma unroll
                    for (int n = 0; n < 2; ++n) acc[a][b][m][n] = (f32x4){0.f, 0.f, 0.f, 0.f};
        cur = nxt; cA = nA; cB = nB; ++ui;
        if constexpr (ALIGN_EPI) { if (wr == 1) PG8_BAR; }
    }
    PG8_WAIT_V(0);
    if constexpr (!ALIGN_EPI) { if (wr == 0) PG8_BAR; }
    PG8_BAR;
#undef PG8_RA
#undef PG8_CA
#undef PG8_SA
#undef PG8_SB
#undef PG8_STAGE
#undef PG8_LDA
#undef PG8_LDB
#undef PG8_MMA
#undef PG8_WAIT_V
#undef PG8_WAIT_L
#undef PG8_BAR
#undef PG8_SCHED
}
}
namespace att {
#define ALAS __attribute__((address_space(3)))
typedef short bf16x8 __attribute__((ext_vector_type(8)));
typedef short s16x4 __attribute__((ext_vector_type(4)));
typedef short v4i16_t __attribute__((ext_vector_type(4)));
typedef float f32x16 __attribute__((ext_vector_type(16)));
typedef unsigned u32x4 __attribute__((ext_vector_type(4)));
typedef unsigned u32x2 __attribute__((ext_vector_type(2)));
typedef unsigned short bf16_t;
constexpr int SEQ = 4096, PW = 4352;
constexpr int QA = 0, KA = 512, VA = 640, QB = 768, KB = 1280, VB = 1792;
constexpr float LOG2E = 1.4426950408889634f;
constexpr float SB_EXIT = -40.0f;

__device__ __forceinline__ int crow(int r, int hi) { return (r & 3) + 8 * (r >> 2) + 4 * hi; }
__device__ __forceinline__ unsigned cvtpk(float lo, float hi) { typedef float f2 __attribute__((ext_vector_type(2))); typedef __bf16 b2 __attribute__((ext_vector_type(2))); f2 v = {lo, hi}; b2 b = __builtin_convertvector(v, b2); return __builtin_bit_cast(unsigned, b); }
__device__ __forceinline__ float bflo(unsigned u) { return __uint_as_float(u << 16); }
__device__ __forceinline__ float bfhi(unsigned u) { return __uint_as_float(u & 0xffff0000u); }
__device__ __forceinline__ s16x4 vtr(const ALAS char* p) { return __builtin_bit_cast(s16x4, __builtin_amdgcn_ds_read_tr16_b64_v4i16((ALAS v4i16_t*)p)); }
#define AT_FENCE() asm volatile("" ::: "memory")

__device__ __forceinline__ void pack_tile(const f32x16& x, bf16x8& f0, bf16x8& f1) {
    u32x4 a, b;
    a.x = cvtpk(x[0], x[1]); a.y = cvtpk(x[2], x[3]); a.z = cvtpk(x[4], x[5]); a.w = cvtpk(x[6], x[7]);
    b.x = cvtpk(x[8], x[9]); b.y = cvtpk(x[10], x[11]); b.z = cvtpk(x[12], x[13]); b.w = cvtpk(x[14], x[15]);
    f0 = __builtin_bit_cast(bf16x8, a); f1 = __builtin_bit_cast(bf16x8, b);
}
__device__ __forceinline__ void v_load(u32x4 (&vr)[4], const bf16_t* Vp, int lane) {
    const unsigned lo = (unsigned)((lane >> 3) * PW + 8 * (lane & 7)) * 2u;
#pragma unroll
    for (int i = 0; i < 4; ++i) vr[i] = *(const u32x4*)((const char*)Vp + (lo + (unsigned)(8 * i * PW * 2)));
}
__device__ __forceinline__ void v_store(const u32x4 (&vr)[4], ALAS char* vl, int lane) {
#pragma unroll
    for (int i = 0; i < 4; ++i) *(ALAS u32x4*)(vl + (8 * i + (lane >> 3)) * 128 + 16 * (lane & 7)) = vr[i];
}
__device__ __forceinline__ void k_load(u32x4 (&kr)[4], const bf16_t* Kp, int lane) {
    const unsigned lo = (unsigned)((lane >> 3) * PW + 8 * (lane & 7)) * 2u;
#pragma unroll
    for (int i = 0; i < 4; ++i) kr[i] = *(const u32x4*)((const char*)Kp + (lo + (unsigned)(8 * i * PW * 2)));
}
__device__ __forceinline__ void k_store(const u32x4 (&kr)[4], ALAS char* kl, int lane) {
#pragma unroll
    for (int i = 0; i < 4; ++i) { const int row = 8 * i + (lane >> 3); *(ALAS u32x4*)(kl + row * 128 + 16 * ((lane & 7) ^ (row & 7))) = kr[i]; }
}
__device__ __forceinline__ void k_frags(u32x4 (&f)[4], const ALAS char* kl, int r32, int hi) {
#pragma unroll
    for (int ks = 0; ks < 4; ++ks) f[ks] = *(const ALAS u32x4*)(kl + r32 * 128 + 16 * ((2 * ks + hi) ^ (r32 & 7)));
}
__device__ __forceinline__ void pv(f32x16& o0, f32x16& o1, const ALAS char* vl, int lane, const bf16x8& p0, const bf16x8& p1) {
    const int g = lane >> 4, i = lane & 15, hi = lane >> 5;
    const ALAS char* base = vl + (4 * hi + (i >> 2)) * 128 + (16 * (g & 1) + 4 * (i & 3)) * 2;
#pragma unroll
    for (int db = 0; db < 2; ++db) {
#pragma unroll
        for (int ks = 0; ks < 2; ++ks) {
            const s16x4 lo = vtr(base + ks * 2048 + db * 64), hh = vtr(base + ks * 2048 + db * 64 + 1024);
            const bf16x8 a = (bf16x8){lo[0], lo[1], lo[2], lo[3], hh[0], hh[1], hh[2], hh[3]};
            if (db == 0) o0 = __builtin_amdgcn_mfma_f32_32x32x16_bf16(a, ks ? p1 : p0, o0, 0, 0, 0);
            else         o1 = __builtin_amdgcn_mfma_f32_32x32x16_bf16(a, ks ? p1 : p0, o1, 0, 0, 0);
        }
    }
}
__device__ __forceinline__ void o_store(const f32x16& o0, const f32x16& o1, float s, bf16_t* Op, int ldo, int r32, int hi, ALAS char* tl, int lane) {
    ALAS char* rowp = tl + r32 * 128 + 8 * hi;
#pragma unroll
    for (int gq = 0; gq < 4; ++gq) {
        u32x2 w0, w1;
        w0.x = cvtpk(o0[4 * gq] * s, o0[4 * gq + 1] * s); w0.y = cvtpk(o0[4 * gq + 2] * s, o0[4 * gq + 3] * s);
        w1.x = cvtpk(o1[4 * gq] * s, o1[4 * gq + 1] * s); w1.y = cvtpk(o1[4 * gq + 2] * s, o1[4 * gq + 3] * s);
        *(ALAS u32x2*)(rowp + 16 * gq) = w0; *(ALAS u32x2*)(rowp + 64 + 16 * gq) = w1;
    }
    AT_FENCE();
#pragma unroll
    for (int i = 0; i < 4; ++i) { const int row = 8 * i + (lane >> 3); const u32x4 v = *(const ALAS u32x4*)(tl + row * 128 + 16 * (lane & 7)); *(u32x4*)(Op + (size_t)row * ldo + 8 * (lane & 7)) = v; }
    AT_FENCE();
}

typedef float f32x4 __attribute__((ext_vector_type(4)));
__device__ __forceinline__ void gu_item_load(f32x4 (&v)[16], const float* wgu, int item, int lane) {
    const int e = item >> 9, q = item & 511, kb = q >> 6, nb = q & 63, g = lane >> 3, c = lane & 7;
    const float* W = wgu + (size_t)e * 1024 * 2048 + (size_t)(128 * kb + 16 * g) * 2048 + 32 * nb + 4 * c;
#pragma unroll
    for (int i = 0; i < 16; ++i) v[i] = __builtin_nontemporal_load((const f32x4*)(W + (size_t)i * 2048));
}
__device__ __forceinline__ unsigned pk4_e4m3(float a, float b, float c, float d) {
    int r = __builtin_amdgcn_cvt_pk_fp8_f32(__builtin_amdgcn_fmed3f(a, -448.f, 448.f), __builtin_amdgcn_fmed3f(b, -448.f, 448.f), 0, false);
    r = __builtin_amdgcn_cvt_pk_fp8_f32(__builtin_amdgcn_fmed3f(c, -448.f, 448.f), __builtin_amdgcn_fmed3f(d, -448.f, 448.f), r, true); return (unsigned)r; }
__device__ __forceinline__ void gu_item_store(const f32x4 (&v)[16], unsigned char* WGU8, int item, int lane) {
    const int e = item >> 9, q = item & 511, kb = q >> 6, nb = q & 63, g = lane >> 3, c = lane & 7, n0 = 32 * nb;
    const int c0 = n0 & 1023, drow0 = 256 * (c0 >> 7) + (n0 >= 1024 ? 128 : 0) + (c0 & 127);
    unsigned char* dst = WGU8 + (size_t)e * 2048 * 1024 + (size_t)(drow0 + 4 * c) * 1024 + 128 * kb + 16 * g;
#pragma unroll
    for (int j = 0; j < 4; ++j) { u32x4 o;
#pragma unroll
        for (int qq = 0; qq < 4; ++qq) o[qq] = pk4_e4m3(v[4 * qq][j] * 32.0f, v[4 * qq + 1][j] * 32.0f, v[4 * qq + 2][j] * 32.0f, v[4 * qq + 3][j] * 32.0f);
        __builtin_nontemporal_store(o, (u32x4*)(dst + (size_t)j * 1024)); }
}
constexpr int GU_ITEMS = 32 * 8 * 64;

__device__ __forceinline__ void kv_dma(__amdgpu_buffer_rsrc_t rs, unsigned koff, unsigned voff, ALAS char* buf, int lane) {
    const int r = lane >> 3, c = lane & 7;
    const unsigned ko = (unsigned)(r * PW + 8 * (c ^ r)) * 2u, vo = (unsigned)(r * PW + 8 * c) * 2u;
#pragma unroll
    for (int i = 0; i < 4; ++i) {
        __builtin_amdgcn_raw_ptr_buffer_load_lds(rs, (ALAS unsigned*)(buf + i * 1024), 16, (int)ko, (int)(koff + (unsigned)(8 * i * PW * 2)), 0, 0);
        __builtin_amdgcn_raw_ptr_buffer_load_lds(rs, (ALAS unsigned*)(buf + 4096 + i * 1024), 16, (int)vo, (int)(voff + (unsigned)(8 * i * PW * 2)), 0, 0);
    }
}
#define AT_WAIT_V(n) asm volatile("s_waitcnt vmcnt(" #n ")" ::: "memory")
#define AT_WAIT_L0() asm volatile("s_waitcnt lgkmcnt(0)" ::: "memory")

__device__ __forceinline__ void sb_unit(const bf16_t* P, __amdgpu_buffer_rsrc_t rs, unsigned pbase, bf16_t* YB, int b, int head, int qblk, ALAS char* wl, int lane) {
    const int r32 = lane & 31, hi = lane >> 5;
    const size_t row0 = (size_t)b * SEQ + 32 * qblk;
    const bf16_t* Qp = P + row0 * PW + QB + 64 * head;
    bf16x8 qf[4];
#pragma unroll
    for (int ks = 0; ks < 4; ++ks) qf[ks] = *(const bf16x8*)(Qp + (size_t)r32 * PW + 16 * ks + 8 * hi);
    bf16x8 U0, U1;
#pragma unroll
    for (int j = 0; j < 8; ++j) { const int k0 = 8 * (j >> 2) + 4 * hi + (j & 3); U0[j] = (k0 > r32) ? (short)0x3F80 : (short)0; U1[j] = (16 + k0 > r32) ? (short)0x3F80 : (short)0; }
    float C = 0.f;
    f32x16 o0 = {}, o1 = {};
    AT_WAIT_L0(); kv_dma(rs, pbase + (unsigned)(row0 * PW + KB + 64 * head) * 2u, pbase + (unsigned)(row0 * PW + VB + 64 * head) * 2u, wl, lane);
    for (int j = 0; j <= qblk; ++j) {
        const size_t krow0 = (size_t)b * SEQ + 32 * (qblk - j);
        ALAS char* kl = wl + (j & 1) * 8192; ALAS char* vl = kl + 4096;
        if (j < qblk) { AT_WAIT_L0(); kv_dma(rs, pbase + (unsigned)((krow0 - 32) * PW + KB + 64 * head) * 2u, pbase + (unsigned)((krow0 - 32) * PW + VB + 64 * head) * 2u, wl + ((j + 1) & 1) * 8192, lane); AT_WAIT_V(8); }
        else AT_WAIT_V(0);
        u32x4 kf[4]; k_frags(kf, kl, r32, hi);
        f32x16 z = {};
#pragma unroll
        for (int ks = 0; ks < 4; ++ks) z = __builtin_amdgcn_mfma_f32_32x32x16_bf16(__builtin_bit_cast(bf16x8, kf[ks]), qf[ks], z, 0, 0, 0);
        f32x16 lk, ls;
        int rq = r32; asm volatile("" : "+v"(rq));
#pragma unroll
        for (int r = 0; r < 16; ++r) {
            const float z2 = z[r];
            const float t = __builtin_amdgcn_exp2f(-fabsf(z2));
            const float l = __builtin_amdgcn_logf(1.0f + t);
            float lkv = -(fmaxf(z2, 0.f) + l);
            float lsv = fminf(z2, 0.f) - l;
            if (j == 0 && !(crow(r, hi) < rq)) { lkv = 0.f; lsv = -INFINITY; }
            lk[r] = lkv; ls[r] = lsv;
        }
        bf16x8 x0, x1; pack_tile(lk, x0, x1);
        f32x16 Y;
#pragma unroll
        for (int r = 0; r < 16; ++r) Y[r] = C;
        Y = __builtin_amdgcn_mfma_f32_32x32x16_bf16(U0, x0, Y, 0, 0, 0);
        Y = __builtin_amdgcn_mfma_f32_32x32x16_bf16(U1, x1, Y, 0, 0, 0);
        const float cn = Y[0] + lk[0];
        C = __shfl(cn, r32);
        f32x16 w;
#pragma unroll
        for (int r = 0; r < 16; ++r) w[r] = __builtin_amdgcn_exp2f(ls[r] + Y[r]);
        bf16x8 p0, p1; pack_tile(w, p0, p1);
        AT_FENCE(); pv(o0, o1, vl, lane, p0, p1); AT_FENCE();
        if (__all(C < SB_EXIT)) break;
    }
    AT_WAIT_V(0); AT_WAIT_L0();
    o_store(o0, o1, 1.0f, YB + row0 * 1024 + 512 + 64 * head, 1024, r32, hi, wl, lane);
}

__device__ __forceinline__ void swa_unit(const bf16_t* P, __amdgpu_buffer_rsrc_t rs, unsigned pbase, bf16_t* YA, const float* qnw, const float* knw, const float* sinks, int b, int head, int qblk, ALAS char* wl, int lane) {
    const int r32 = lane & 31, hi = lane >> 5, kvh = head >> 2;
    const size_t row0 = (size_t)b * SEQ + 32 * qblk;
    const float slope2 = exp2f(-(float)(head + 1)) * LOG2E;
    bf16x8 qf[4];
    {
        const bf16_t* Qp = P + row0 * PW + QA + 64 * head + (size_t)r32 * PW + 8 * hi;
        u32x4 raw[4]; float ss = 0.f;
#pragma unroll
        for (int ks = 0; ks < 4; ++ks) { raw[ks] = *(const u32x4*)(Qp + 16 * ks);
#pragma unroll
            for (int d = 0; d < 4; ++d) { const float a = bflo(raw[ks][d]), c = bfhi(raw[ks][d]); ss += a * a + c * c; } }
        ss += __shfl_xor(ss, 32);
        const float rq = rsqrtf(ss * (1.0f / 64.0f) + 1e-5f) * (0.125f * LOG2E);
#pragma unroll
        for (int ks = 0; ks < 4; ++ks) { u32x4 o;
#pragma unroll
            for (int d = 0; d < 4; ++d) { const int dd = 16 * ks + 8 * hi + 2 * d;
                o[d] = cvtpk(bflo(raw[ks][d]) * rq * (qnw[dd] * knw[dd]), bfhi(raw[ks][d]) * rq * (qnw[dd + 1] * knw[dd + 1])); }
            qf[ks] = __builtin_bit_cast(bf16x8, o); }
    }
    float m2 = sinks[head] * LOG2E;
    float l = (hi == 0) ? 1.0f : 0.f;
    f32x16 o0 = {}, o1 = {};
    AT_WAIT_L0(); kv_dma(rs, pbase + (unsigned)(row0 * PW + KA + 64 * kvh) * 2u, pbase + (unsigned)(row0 * PW + VA + 64 * kvh) * 2u, wl, lane);
    for (int j = 0; j < 5; ++j) {
        const int kb = qblk - j; if (kb < 0) break;
        const size_t krow0 = (size_t)b * SEQ + 32 * kb;
        ALAS char* kl = wl + (j & 1) * 8192; ALAS char* vl = kl + 4096;
        if (j < 4 && kb > 0) { AT_WAIT_L0(); kv_dma(rs, pbase + (unsigned)((krow0 - 32) * PW + KA + 64 * kvh) * 2u, pbase + (unsigned)((krow0 - 32) * PW + VA + 64 * kvh) * 2u, wl + ((j + 1) & 1) * 8192, lane); AT_WAIT_V(8); }
        else AT_WAIT_V(0);
        u32x4 raw[4]; k_frags(raw, kl, r32, hi);
        bf16x8 kf[4];
        {
            float ss = 0.f;
#pragma unroll
            for (int ks = 0; ks < 4; ++ks) {
#pragma unroll
                for (int d = 0; d < 4; ++d) { const float a = bflo(raw[ks][d]), c = bfhi(raw[ks][d]); ss += a * a + c * c; } }
            ss += __shfl_xor(ss, 32);
            const float rk = rsqrtf(ss * (1.0f / 64.0f) + 1e-5f);
#pragma unroll
            for (int ks = 0; ks < 4; ++ks) { u32x4 o;
#pragma unroll
                for (int d = 0; d < 4; ++d) o[d] = cvtpk(bflo(raw[ks][d]) * rk, bfhi(raw[ks][d]) * rk);
                kf[ks] = __builtin_bit_cast(bf16x8, o); }
        }
        f32x16 z = {};
#pragma unroll
        for (int ks = 0; ks < 4; ++ks) z = __builtin_amdgcn_mfma_f32_32x32x16_bf16(kf[ks], qf[ks], z, 0, 0, 0);
        float tmax = -INFINITY;
        int rq = r32; asm volatile("" : "+v"(rq));
#pragma unroll
        for (int r = 0; r < 16; ++r) {
            const int c = crow(r, hi);
            float s2 = z[r] - slope2 * (float)(32 * j + rq - c);
            if (j == 0 && c > rq) s2 = -INFINITY;
            if (j == 4 && !(c > rq)) s2 = -INFINITY;
            z[r] = s2; tmax = fmaxf(tmax, s2);
        }
        tmax = fmaxf(tmax, __shfl_xor(tmax, 32));
        const float mn = fmaxf(m2, tmax);
        const float alpha = __builtin_amdgcn_exp2f(m2 - mn);
        m2 = mn; l *= alpha;
#pragma unroll
        for (int r = 0; r < 16; ++r) { o0[r] *= alpha; o1[r] *= alpha; }
        float ps = 0.f;
#pragma unroll
        for (int r = 0; r < 16; ++r) { const float p = __builtin_amdgcn_exp2f(z[r] - mn); z[r] = p; ps += p; }
        l += ps;
        bf16x8 p0, p1; pack_tile(z, p0, p1);
        AT_FENCE(); pv(o0, o1, vl, lane, p0, p1); AT_FENCE();
    }
    l += __shfl_xor(l, 32);
    AT_WAIT_L0();
    o_store(o0, o1, 1.0f / l, YA + row0 * 1024 + 64 * head, 1024, r32, hi, wl, lane);
}

__device__ __forceinline__ void attn_phase(ALAS char* lds, const bf16_t* P, bf16_t* YA, bf16_t* YB, const float* qnw, const float* knw, const float* sinks, const float* wgu, unsigned char* WGU8, const void* wsbase, unsigned pbase, int vcu, int G, int wave, int lane) {
    const __amdgpu_buffer_rsrc_t rs = __builtin_amdgcn_make_buffer_rsrc((void*)wsbase, 0, 0x7fffffff, 0x00020000);
    ALAS char* wl = lds + wave * 16384;
    const int ngrp = 2048;
    int item = vcu * 8 + wave;
    for (int g0 = vcu, it = 0; g0 < ngrp; g0 += G, ++it) {
        const int gi = (G == 256) ? (g0 & ~255) + ((vcu + 17 * it) & 255) : g0;
        const int U = gi * 8 + wave;
        const int qblk = U & 127, head = (U >> 7) & 7, b = (U >> 10) & 7, kind = U >> 13;
        int ln = lane; asm volatile("" : "+v"(ln));
        f32x4 wv[16]; const bool have = item < GU_ITEMS;
        if (have) gu_item_load(wv, wgu, item, ln);
        if (kind == 0) swa_unit(P, rs, pbase, YA, qnw, knw, sinks, b, head, qblk, wl, ln);
        else sb_unit(P, rs, pbase, YB, b, head, qblk, wl, ln);
        if (have) { gu_item_store(wv, WGU8, item, ln); item += 8 * G; }
    }
    for (; item < GU_ITEMS; item += 8 * G) { f32x4 wv[16]; gu_item_load(wv, wgu, item, lane); gu_item_store(wv, WGU8, item, lane); }
}
}
constexpr int NWAVES = 8;
constexpr int N_LAUNCHES = MK_N_LAUNCHES;
constexpr int PER_PHASE = 9;

constexpr int BATCH = 8, SEQ = 4096, D = 1024, M = BATCH * SEQ, INW = 4352, NE = 32, TOPK = 4, DFF = 1024;
constexpr int GA_COL = 2304, GB_COL = 3328;
constexpr int ECAP = 32768;
constexpr int MAXTILES = 544;
constexpr float NORM_EPS = 1e-5f;
constexpr float QB_SCALE = 0.125f * 1.4426950408889634f;

constexpr size_t MiB = 1u << 20;
constexpr size_t WS_CTL = 0, CTL_ZERO_BYTES = 1 * MiB;
constexpr size_t WS_WIN = 2 * MiB;
constexpr size_t WS_PA = 11 * MiB, WS_WO = 13 * MiB;
constexpr size_t WS_LAID = 16 * MiB, WS_LRS = 20 * MiB, WS_LGATE = 24 * MiB;
constexpr size_t WS_RTAB = 28 * MiB;
constexpr size_t WS_WIN8 = 29 * MiB;
constexpr size_t WS_WGU = 32 * MiB;
constexpr size_t WS_WD = 160 * MiB;
constexpr size_t WS_XN = 224 * MiB;
constexpr size_t WS_YA = 288 * MiB;
constexpr size_t WS_MG = 352 * MiB;
constexpr size_t WS_PROJ = 416 * MiB;
constexpr size_t WS_YBUF = 688 * MiB;
constexpr size_t WS_XN8 = 944 * MiB;
constexpr size_t WS_END = 976 * MiB;
constexpr int CW_TMO = 0, CW_CODE = 1, CW_CNT = 64  , CW_BAR = 4096;

constexpr int RING_OFF = 0, RING_BYTES = 131072;
constexpr int LDS_BYTES = 163840;
constexpr int XTRA_OFF = RING_BYTES;
constexpr int TILETAB_OFF = XTRA_OFF;
constexpr int CNT_OFF = TILETAB_OFF + 2304;
constexpr int ROWTAB_OFF = CNT_OFF + 512;
constexpr int EPIMETA_OFF = ROWTAB_OFF + 18 * 1024 + 256;
constexpr int LDSCTL_OFF = LDS_BYTES - 1024, MISC_OFF = LDSCTL_OFF + 320;
static_assert(EPIMETA_OFF == (int)pg8::EPIMETA && EPIMETA_OFF + 2 * (int)pg8::EPIMETA_IMG <= LDSCTL_OFF, "LDS map");
static_assert(8 * 16640 <= LDSCTL_OFF, "P0 scratch");

#define GAS __attribute__((address_space(1)))
#define LAS __attribute__((address_space(3)))
typedef unsigned short bf16;
typedef unsigned v4u __attribute__((ext_vector_type(4)));
typedef float f32x4 __attribute__((ext_vector_type(4)));
typedef float f32x16 __attribute__((ext_vector_type(16)));
typedef short bf16x8 __attribute__((ext_vector_type(8)));
typedef GAS unsigned gu32;
#define RLX_AGENT __ATOMIC_RELAXED, __HIP_MEMORY_SCOPE_AGENT
#define LDS_WAIT() asm volatile("s_waitcnt lgkmcnt(0)" ::: "memory")
#define VM_WAIT() asm volatile("s_waitcnt vmcnt(0)" ::: "memory")
__device__ __forceinline__ unsigned pk2(float lo, float hi) { return pg8::cvt_pk_bf16(lo, hi); }

#define XB_TMO      128
#define XB_XCNT(j)  (256  + 64 * (j))
#define XB_XSUB(j)  (1280 + 64 * (j))
#define XB_XGEN(j)  (2304 + 64 * (j))
#define XB_TOP      3328
#define XB_TOPGEN   3392
#define XCD_BAR_WORDS 3456
#define XB_SPIN_CAP (1u << 22)
__device__ __forceinline__ unsigned xb_ld(unsigned* p)              { return __hip_atomic_load(p, __ATOMIC_RELAXED, __HIP_MEMORY_SCOPE_AGENT); }
__device__ __forceinline__ unsigned xb_add(unsigned* p, unsigned v) { return __hip_atomic_fetch_add(p, v, __ATOMIC_RELAXED, __HIP_MEMORY_SCOPE_AGENT); }
__device__ __forceinline__ unsigned xb_xcc_id() { return (unsigned)__builtin_amdgcn_s_getreg((3 << 11) | 20) & 0xFu; }
#define XB_SPIN(cond, bar) do { unsigned _sp = 0; while (cond) { __builtin_amdgcn_s_sleep(1); \
    if ((++_sp & 255u) == 0u) { if (xb_ld(&(bar)[XB_TMO])) break; if (_sp > XB_SPIN_CAP) { atomicAdd(&(bar)[XB_TMO], 1u); break; } } } } while (0)
struct XcdBarrier { unsigned* bar; unsigned x; volatile LAS unsigned* st; };
__device__ __forceinline__ XcdBarrier xcd_barrier_post(unsigned* bar, volatile LAS unsigned* st, bool tid0) {
    XcdBarrier b; b.bar = bar; b.x = xb_xcc_id(); b.st = st;
    if (tid0) (void)xb_add(&bar[XB_XCNT(b.x)], 1u);
    return b;
}
__device__ __forceinline__ void xcd_barrier_complete(unsigned* bar, unsigned x, unsigned& nloc, unsigned& nx) {
    const unsigned G = gridDim.x * gridDim.y * gridDim.z;
    unsigned sum, cnt, mine, sp = 0u;
    for (;;) {
        sum = 0u; cnt = 0u; mine = 0u;
#pragma unroll
        for (unsigned j = 0; j < 16; ++j) { const unsigned c = xb_ld(&bar[XB_XCNT(j)]); sum += c; cnt += (c > 0u) ? 1u : 0u; mine = (j == x) ? c : mine; }
        if (sum == G) break;
        __builtin_amdgcn_s_sleep(1);
        if ((++sp & 255u) == 0u) { if (xb_ld(&bar[XB_TMO])) break; if (sp > XB_SPIN_CAP) { atomicAdd(&bar[XB_TMO], 1u); break; } }
    }
    nloc = mine > 0u ? mine : 1u; nx = cnt > 0u ? cnt : 1u;
}
__device__ __forceinline__ void xcd_barrier(const XcdBarrier& b, bool tid0) {
    asm volatile("s_waitcnt vmcnt(0)" ::: "memory");
    __syncthreads();
    if (tid0) {
        unsigned* bar = b.bar;
        __builtin_amdgcn_s_waitcnt(0);
        unsigned nloc = b.st[0], nx = b.st[1];
        if (nloc == 0u) { xcd_barrier_complete(bar, b.x, nloc, nx); b.st[0] = nloc; b.st[1] = nx; }
        const unsigned old = xb_add(&bar[XB_XSUB(b.x)], 1u);
        const unsigned gen = old / nloc;
        if (old + 1u == (gen + 1u) * nloc) {
            __builtin_amdgcn_fence(__ATOMIC_RELEASE, "agent");
            asm volatile("s_waitcnt vmcnt(0)" ::: "memory");
            const unsigned og = xb_add(&bar[XB_TOP], 1u);
            const unsigned tg = og / nx;
            if (og + 1u == (tg + 1u) * nx) xb_add(&bar[XB_TOPGEN], 1u);
            else XB_SPIN(xb_ld(&bar[XB_TOPGEN]) == tg, bar);
            __builtin_amdgcn_fence(__ATOMIC_ACQUIRE, "agent");
            xb_add(&bar[XB_XGEN(b.x)], 1u);
            asm volatile("s_waitcnt vmcnt(0)" ::: "memory");
        } else {
            XB_SPIN(xb_ld(&bar[XB_XGEN(b.x)]) == gen, bar);
            __builtin_amdgcn_fence(__ATOMIC_ACQUIRE, "agent");
            asm volatile("s_waitcnt vmcnt(0)" ::: "memory");
        }
    }
    __syncthreads();
}

struct Frame {
    LAS unsigned char* lds;
    volatile LAS unsigned* MISC;
    gu32* ctl;
    int wave;
    int vcu, G;
    float* out;
    unsigned char* ws;
};

__device__ __forceinline__ float wave_sum(float v) {
#pragma unroll
    for (int o = 1; o < 64; o <<= 1) v += __shfl_xor(v, o);
    return v;
}

template <bool FP8, bool DPERM = false, bool WPERM = false>
__device__ __forceinline__ void p0_item(const float* W, int N, void* WT, int Kdst, int ksrc, int kdst, int n0, int drow0, float scale, int lane) {
    const int g = lane >> 3, c = lane & 7;
    f32x4 v[16];
#pragma unroll
    for (int i = 0; i < 16; ++i) v[i] = __builtin_nontemporal_load((const f32x4*)(W + (size_t)(ksrc + 16 * g + i) * N + n0 + 4 * c));
#pragma unroll
    for (int j = 0; j < 4; ++j) {
        if constexpr (FP8) { v4u o;
#pragma unroll
            for (int q = 0; q < 4; ++q) o[q] = pg8::pk4_fp8(v[4 * q][j] * scale, v[4 * q + 1][j] * scale, v[4 * q + 2][j] * scale, v[4 * q + 3][j] * scale);
            int drow = drow0 + 4 * c + j;
            if constexpr (DPERM) { const int n = drow & 255; drow = (drow & ~255) + 128 * ((n >> 3) & 1) + 32 * (n >> 6) + 8 * ((n >> 4) & 3) + (n & 7); }
            if constexpr (WPERM) { const int n = drow & 255; drow = (drow & ~255) + 128 * ((n >> 5) & 1) + 32 * (n >> 6) + (n & 31); }
            if constexpr (DPERM) __builtin_nontemporal_store(o, (v4u*)((unsigned char*)WT + (size_t)drow * Kdst + kdst + 16 * g)); else *(v4u*)((unsigned char*)WT + (size_t)drow * Kdst + kdst + 16 * g) = o;
        } else { v4u o0, o1;
#pragma unroll
            for (int q = 0; q < 4; ++q) { o0[q] = pk2(v[2 * q][j] * scale, v[2 * q + 1][j] * scale); o1[q] = pk2(v[8 + 2 * q][j] * scale, v[9 + 2 * q][j] * scale); }
            int drow = drow0 + 4 * c + j;
            if constexpr (WPERM) { const int n = drow & 255; drow = (drow & ~255) + 128 * ((n >> 5) & 1) + 32 * (n >> 6) + (n & 31); }
            bf16* dp = (bf16*)WT + (size_t)drow * Kdst + kdst + 16 * g; *(v4u*)dp = o0; *(v4u*)(dp + 8) = o1; }
    }
}
__device__ __forceinline__ void p0_prologue(Frame& F, const float* x, const float* anw, const float* win, const float* wpa, const float* wpb, const float* wo, const float* wgu, const float* wd, const float* fnw, const float* rw) {
    (void)wgu; (void)wd;
    const int lane = pg8::lane_now();
    const int gw = F.vcu * NWAVES + F.wave, NGW = F.G * NWAVES;
    bf16* WIN = (bf16*)(F.ws + WS_WIN); bf16* PA = (bf16*)(F.ws + WS_PA); bf16* WO = (bf16*)(F.ws + WS_WO);
    bf16* XN = (bf16*)(F.ws + WS_XN);
    constexpr int I_IN = 8 * 136, I_PA = 4 * 32, I_WO = 8 * 32;
    constexpr int NITEMS = I_IN + 2 * I_PA + I_WO;
    for (int it = gw; it < NITEMS; it += NGW) {
        int r = it;
        if (r < I_IN) { const int kb = r / 136, nb = r % 136, n0 = 32 * nb; const float sc = (n0 >= 768 && n0 < 1280) ? QB_SCALE : 1.0f;
            if (n0 < GA_COL) p0_item<false, false, true>(win, INW, WIN, 1024, 128 * kb, 128 * kb, n0, n0, sc, lane);
            else p0_item<true, false, true>(win, INW, F.ws + WS_WIN8, 1024, 128 * kb, 128 * kb, n0, n0 - GA_COL, 32.0f, lane);
            continue; } r -= I_IN;
        if (r < I_PA) { const int kb = r / 32, nb = r % 32; p0_item<false>(wpa, 1024, PA, 1024, 128 * kb, 128 * kb, 32 * nb, 32 * nb, 1.0f, lane); continue; } r -= I_PA;
        if (r < I_PA) { const int kb = r / 32, nb = r % 32; p0_item<false>(wpb, 1024, PA, 1024, 128 * kb, 512 + 128 * kb, 32 * nb, 32 * nb, 1.0f, lane); continue; } r -= I_PA;
        { const int kb = r / 32, nb = r % 32; p0_item<false>(wo, 1024, WO, 1024, 128 * kb, 128 * kb, 32 * nb, 32 * nb, 1.0f, lane); }
    }
    for (int ks = gw; ks < 64; ks += NGW) { const int l = lane, e = l & 31, hh = l >> 5;
        float v[8];
#pragma unroll
        for (int j = 0; j < 8; ++j) { const int k = 16 * ks + 8 * hh + j; v[j] = fnw[k] * rw[k * NE + e]; }
        v4u oh, ol;
#pragma unroll
        for (int j = 0; j < 4; ++j) { const unsigned ph = pk2(v[2 * j], v[2 * j + 1]); oh[j] = ph; ol[j] = pk2(v[2 * j] - pg8::bf_lo(ph), v[2 * j + 1] - pg8::bf_hi(ph)); }
        *(v4u*)(F.ws + WS_RTAB + (size_t)(ks * 64 + l) * 16) = oh; *(v4u*)(F.ws + WS_RTAB + 65536 + (size_t)(ks * 64 + l) * 16) = ol; }
    f32x4 wv[4];
#pragma unroll
    for (int j = 0; j < 4; ++j) wv[j] = *((const f32x4*)anw + lane + 64 * j);
    for (int m = gw; m < M; m += 2 * NGW) {
        const f32x4* xr0 = (const f32x4*)(x + (size_t)m * D) + lane; const f32x4* xr1 = (const f32x4*)(x + (size_t)(m + NGW) * D) + lane;
        f32x4 v0[4], v1[4]; float s0 = 0.f, s1 = 0.f;
#pragma unroll
        for (int j = 0; j < 4; ++j) { v0[j] = __builtin_nontemporal_load(xr0 + 64 * j); v1[j] = __builtin_nontemporal_load(xr1 + 64 * j); }
#pragma unroll
        for (int j = 0; j < 4; ++j) { s0 += (v0[j].x * v0[j].x + v0[j].y * v0[j].y) + (v0[j].z * v0[j].z + v0[j].w * v0[j].w); s1 += (v1[j].x * v1[j].x + v1[j].y * v1[j].y) + (v1[j].z * v1[j].z + v1[j].w * v1[j].w); }
        const float r0 = rsqrtf(wave_sum(s0) * (1.f / D) + NORM_EPS), r1 = rsqrtf(wave_sum(s1) * (1.f / D) + NORM_EPS);
        unsigned long long* o0 = (unsigned long long*)(XN + (size_t)m * D) + lane; unsigned long long* o1 = (unsigned long long*)(XN + (size_t)(m + NGW) * D) + lane;
        unsigned* q0 = (unsigned*)(F.ws + WS_XN8 + (size_t)m * D) + lane; unsigned* q1 = (unsigned*)(F.ws + WS_XN8 + (size_t)(m + NGW) * D) + lane;
#pragma unroll
        for (int j = 0; j < 4; ++j) { const f32x4 y0 = v0[j] * r0 * wv[j], y1 = v1[j] * r1 * wv[j];
            o0[64 * j] = (unsigned long long)pk2(y0.x, y0.y) | ((unsigned long long)pk2(y0.z, y0.w) << 32); o1[64 * j] = (unsigned long long)pk2(y1.x, y1.y) | ((unsigned long long)pk2(y1.z, y1.w) << 32);
            q0[64 * j] = pg8::pk4_fp8(y0.x, y0.y, y0.z, y0.w); q1[64 * j] = pg8::pk4_fp8(y1.x, y1.y, y1.z, y1.w); }
    }
}

__device__ __forceinline__ int crow16(int r, int hi) { return (r & 3) + 8 * (r >> 2) + 4 * hi; }
#define RT_BETTER(xv, xi, yv, yi) ((xv) > (yv) || ((xv) == (yv) && (xi) < (yi)))
#define RT_CSWAP(va, ia, vb, ib) do { if (RT_BETTER(vb, ib, va, ia)) { const float tv_ = va; va = vb; vb = tv_; const int ti_ = ia; ia = ib; ib = ti_; } } while (0)
__device__ __forceinline__ void p5_route(Frame& F, const float* x, const float* fnw, const float* rb, const float* wd, bool dummy = false) {
    LAS float* wnl = (LAS float*)(F.lds + 140288);
    LAS int* lcnt = (LAS int*)(F.lds + 144384);
    LAS int* lbase = lcnt + 32;
    LAS float* part = (LAS float*)(F.lds);
    unsigned char* HNU = F.ws + WS_XN;
    int* laid = (int*)(F.ws + (dummy ? WS_YBUF : WS_LAID)); float* lrs = (float*)(F.ws + (dummy ? WS_YBUF + 4 * MiB : WS_LRS)); float* lgate = (float*)(F.ws + (dummy ? WS_YBUF + 8 * MiB : WS_LGATE));
    unsigned* gcnt = (unsigned*)(F.ctl + (dummy ? 16384 : CW_CNT));
    const int lane = pg8::lane_now(), wave = F.wave, tid = wave * 64 + lane, r32 = lane & 31, hi = lane >> 5;
    typedef unsigned u32x2_t __attribute__((ext_vector_type(2)));
    const __amdgpu_buffer_rsrc_t rsx = __builtin_amdgcn_make_buffer_rsrc((void*)x, 0, 0x7fffffff, 0x00020000);
    const __amdgpu_buffer_rsrc_t rsw = __builtin_amdgcn_make_buffer_rsrc((void*)F.ws, 0, 0x7fffffff, 0x00020000);
    LAS unsigned char* wb = F.lds + wave * 16384;
    bf16x8 whi[8], wlo[8];
#pragma unroll
    for (int q = 0; q < 8; ++q) { const size_t e = ((size_t)(8 * wave + q) * 64 + lane) * 16; whi[q] = *(const bf16x8*)(F.ws + WS_RTAB + e); wlo[q] = *(const bf16x8*)(F.ws + WS_RTAB + 65536 + e); }
#pragma clang loop vectorize(disable) unroll(disable)
    for (int idx = tid; idx < 1024; idx += NWAVES * 64) wnl[idx] = fnw[idx];
    unsigned vx[4];
#pragma unroll
    for (int i = 0; i < 4; ++i) { const int row = 8 * i + (lane >> 3); vx[i] = (unsigned)(row * 4096 + 16 * ((lane & 7) ^ ((row >> 1) & 7))); }
    const unsigned va = (unsigned)((lane >> 2) * 2048 + 16 * ((lane & 3) ^ ((lane >> 4) & 3)));
    const int fx = (r32 >> 1) & 7, fa = (r32 >> 2) & 3;
    int witem = F.vcu * NWAVES + wave;
    for (int tb = F.vcu; tb < M / 128; tb += F.G) {
        const int tok0 = tb * 128;
        if (tid < 32) lcnt[tid] = 0;
        f32x16 acc[4]; float ss[4];
#pragma unroll
        for (int g = 0; g < 4; ++g) { acc[g] = (f32x16){}; ss[g] = 0.f; }
#define P5_DMA(s_) do { const int g_ = (s_) >> 2, st_ = (s_) & 3; LAS unsigned char* b_ = wb + ((s_) & 1) * 6144; \
            const unsigned sx_ = (unsigned)(tok0 + 32 * g_) * 4096u + (unsigned)(128 * wave + 32 * st_) * 4u, sa_ = (unsigned)WS_YA + (unsigned)(tok0 + 32 * g_) * 2048u + (unsigned)(128 * wave + 32 * st_) * 2u; \
            _Pragma("unroll") for (int i = 0; i < 4; ++i) __builtin_amdgcn_raw_ptr_buffer_load_lds(rsx, (LAS unsigned*)(b_ + i * 1024), 16, (int)vx[i], (int)sx_, 0, 0); \
            _Pragma("unroll") for (int i = 0; i < 2; ++i) __builtin_amdgcn_raw_ptr_buffer_load_lds(rsw, (LAS unsigned*)(b_ + 4096 + i * 1024), 16, (int)va, (int)(sa_ + (unsigned)(i * 16 * 2048)), 0, 0); } while (0)
        asm volatile("s_waitcnt lgkmcnt(0)" ::: "memory"); __syncthreads();
        P5_DMA(0);
#pragma clang loop unroll(full)
        for (int s = 0; s < 16; ++s) {
            const int g = s >> 2, st = s & 3;
            LAS unsigned char* bs = wb + (s & 1) * 6144; LAS unsigned char* hs = wb + 12288;
            if (s < 15) { asm volatile("s_waitcnt lgkmcnt(0)" ::: "memory"); P5_DMA(s + 1); asm volatile("s_waitcnt vmcnt(6)" ::: "memory"); }
            else asm volatile("s_waitcnt vmcnt(0)" ::: "memory");
#pragma unroll
            for (int q = 0; q < 2; ++q) {
                f32x4 a = *(const LAS f32x4*)(bs + r32 * 128 + 16 * ((4 * q + 2 * hi) ^ fx)), b = *(const LAS f32x4*)(bs + r32 * 128 + 16 * ((4 * q + 2 * hi + 1) ^ fx));
                const v4u t_ = *(const LAS v4u*)(bs + 4096 + r32 * 64 + 16 * ((2 * q + hi) ^ fa));
                a.x += pg8::bf_lo(t_.x); a.y += pg8::bf_hi(t_.x); a.z += pg8::bf_lo(t_.y); a.w += pg8::bf_hi(t_.y); b.x += pg8::bf_lo(t_.z); b.y += pg8::bf_hi(t_.z); b.z += pg8::bf_lo(t_.w); b.w += pg8::bf_hi(t_.w);
                ss[g] += (a.x * a.x + a.y * a.y) + (a.z * a.z + a.w * a.w) + (b.x * b.x + b.y * b.y) + (b.z * b.z + b.w * b.w);
                v4u ph, pl;
                ph.x = pk2(a.x, a.y); ph.y = pk2(a.z, a.w); ph.z = pk2(b.x, b.y); ph.w = pk2(b.z, b.w);
                pl.x = pk2(a.x - pg8::bf_lo(ph.x), a.y - pg8::bf_hi(ph.x)); pl.y = pk2(a.z - pg8::bf_lo(ph.y), a.w - pg8::bf_hi(ph.y));
                pl.z = pk2(b.x - pg8::bf_lo(ph.z), b.y - pg8::bf_hi(ph.z)); pl.w = pk2(b.z - pg8::bf_lo(ph.w), b.w - pg8::bf_hi(ph.w));
                const bf16x8 hh = __builtin_bit_cast(bf16x8, ph), hl = __builtin_bit_cast(bf16x8, pl);
                acc[g] = __builtin_amdgcn_mfma_f32_32x32x16_bf16(whi[2 * st + q], hh, acc[g], 0, 0, 0);
                acc[g] = __builtin_amdgcn_mfma_f32_32x32x16_bf16(whi[2 * st + q], hl, acc[g], 0, 0, 0);
                acc[g] = __builtin_amdgcn_mfma_f32_32x32x16_bf16(wlo[2 * st + q], hh, acc[g], 0, 0, 0);
                const int kk = 128 * wave + 32 * st + 16 * q + 8 * hi;
                const f32x4 w0 = *(const LAS f32x4*)(wnl + kk), w1 = *(const LAS f32x4*)(wnl + kk + 4);
                u32x2_t o; o.x = pg8::pk4_fp8(a.x * w0.x, a.y * w0.y, a.z * w0.z, a.w * w0.w); o.y = pg8::pk4_fp8(b.x * w1.x, b.y * w1.y, b.z * w1.z, b.w * w1.w);
                *(LAS u32x2_t*)(hs + r32 * 128 + 16 * (2 * st + q) + 8 * hi) = o;
            }
            if (st == 3) {
                asm volatile("" ::: "memory");
#pragma unroll
                for (int i = 0; i < 4; ++i) { const int row = 8 * i + (lane >> 3); const v4u v = *(const LAS v4u*)(hs + row * 128 + 16 * (lane & 7));
                    *(v4u*)(HNU + (size_t)(tok0 + 32 * g + row) * D + 128 * wave + 16 * (lane & 7)) = v; }
                asm volatile("" ::: "memory");
            }
            __builtin_amdgcn_sched_barrier(0);
        }
#undef P5_DMA
        asm volatile("s_waitcnt vmcnt(0) lgkmcnt(0)" ::: "memory"); __syncthreads();
        {
        const int lane = pg8::lane_now(), tid = wave * 64 + lane, r32 = lane & 31, hi = lane >> 5;
#pragma unroll
        for (int g = 0; g < 4; ++g) {
#pragma unroll
            for (int r = 0; r < 16; ++r) part[((wave * 4 + g) * 17 + r) * 64 + lane] = acc[g][r];
            part[((wave * 4 + g) * 17 + 16) * 64 + lane] = ss[g]; }
        __syncthreads();
        int te[4] = {0, 0, 0, 0}, rk[4] = {0, 0, 0, 0}; float tg[4] = {0.f, 0.f, 0.f, 0.f}; float rstd = 0.f;
        const int token = tok0 + 32 * wave + r32;
        if (wave < 4) {
            f32x16 lg = {}; float sq = 0.f;
#pragma unroll
            for (int w = 0; w < 8; ++w) {
#pragma unroll
                for (int r = 0; r < 16; ++r) lg[r] += part[((w * 4 + wave) * 17 + r) * 64 + lane];
                sq += part[((w * 4 + wave) * 17 + 16) * 64 + lane]; }
            sq += __shfl_xor(sq, 32);
            rstd = rsqrtf(sq * (1.f / D) + NORM_EPS);
            float v0 = -INFINITY, v1 = -INFINITY, v2 = -INFINITY, v3 = -INFINITY; int i0 = 99, i1 = 99, i2 = 99, i3 = 99;
#pragma unroll
            for (int r = 0; r < 16; ++r) { const int e = crow16(r, hi); float v4 = lg[r] * rstd + rb[e]; int i4 = e;
                RT_CSWAP(v3, i3, v4, i4); RT_CSWAP(v2, i2, v3, i3); RT_CSWAP(v1, i1, v2, i2); RT_CSWAP(v0, i0, v1, i1); }
            float ov[4] = {__shfl_xor(v0, 32), __shfl_xor(v1, 32), __shfl_xor(v2, 32), __shfl_xor(v3, 32)};
            int oi[4] = {__shfl_xor(i0, 32), __shfl_xor(i1, 32), __shfl_xor(i2, 32), __shfl_xor(i3, 32)};
#pragma unroll
            for (int q = 0; q < 4; ++q) { float v4 = ov[q]; int i4 = oi[q];
                RT_CSWAP(v3, i3, v4, i4); RT_CSWAP(v2, i2, v3, i3); RT_CSWAP(v1, i1, v2, i2); RT_CSWAP(v0, i0, v1, i1); }
            const float p1 = __expf(v1 - v0), p2 = __expf(v2 - v0), p3 = __expf(v3 - v0), inv = 1.0f / (1.0f + p1 + p2 + p3);
            te[0] = i0; te[1] = i1; te[2] = i2; te[3] = i3; tg[0] = inv; tg[1] = p1 * inv; tg[2] = p2 * inv; tg[3] = p3 * inv;
            if (hi == 0) {
#pragma unroll
                for (int q = 0; q < 4; ++q) rk[q] = atomicAdd((int*)&lcnt[te[q]], 1);
            }
        }
        __syncthreads();
        if (tid < 32) lbase[tid] = (int)atomicAdd(&gcnt[tid * 64], (unsigned)lcnt[tid]);
        __syncthreads();
        if (wave < 4 && hi == 0) {
#pragma unroll
            for (int q = 0; q < 4; ++q) { const size_t pos = (size_t)te[q] * ECAP + lbase[te[q]] + rk[q];
                laid[pos] = token * 4 + q; lrs[pos] = rstd; lgate[pos] = tg[q]; }
        }
        __syncthreads();
        }
    }
    (void)wd; (void)witem;
}

__device__ __forceinline__ int moe_tables(Frame& F) {
    LAS int* tiletab = (LAS int*)(F.lds + TILETAB_OFF); LAS int* cnt = (LAS int*)(F.lds + CNT_OFF); LAS int* tpre = cnt + 32;
    const int tid = F.wave * 64 + pg8::lane_now();
    if (tid < 32) cnt[tid] = (int)__hip_atomic_load(F.ctl + CW_CNT + tid * 64, RLX_AGENT);
    __syncthreads();
    if (tid == 0) { int s = 0; for (int e = 0; e < NE; ++e) { tpre[e] = s; s += (cnt[e] + 255) >> 8; } tpre[NE] = s; }
    __syncthreads();
    const int nM = tpre[NE];
    for (int t = tid; t < nM; t += NWAVES * 64) { int e = 0; for (int q = 1; q < NE; ++q) if (tpre[q] <= t) e = q; tiletab[t] = (e << 16) | (t - tpre[e]); }
    __syncthreads();
    return nM;
}

__device__ __forceinline__ void p8_combine(Frame& F, const float* x, float* dst) {
    typedef float f32x2 __attribute__((ext_vector_type(2)));
    const int gw = F.vcu * NWAVES + F.wave, NGW = F.G * NWAVES, lane = pg8::lane_now();
    const unsigned char* Y = F.ws + WS_YBUF;
    for (int m0 = gw; m0 < M; m0 += 2 * NGW) {
        f32x4 v[2][4]; unsigned w[2][4][4]; unsigned long long at[2][4];
#pragma unroll
        for (int t = 0; t < 2; ++t) { const int m = m0 + t * NGW; const f32x4* orow = (const f32x4*)(x + (size_t)m * D) + lane;
            const unsigned long long* ar = (const unsigned long long*)((const bf16*)(F.ws + WS_YA) + (size_t)m * D) + lane;
#pragma unroll
            for (int j = 0; j < 4; ++j) { v[t][j] = __builtin_nontemporal_load(orow + 64 * j); at[t][j] = __builtin_nontemporal_load(ar + 64 * j); }
#pragma unroll
            for (int q = 0; q < 4; ++q) { const unsigned* yr = (const unsigned*)(Y + (size_t)(m * 4 + q) * D) + lane;
#pragma unroll
                for (int j = 0; j < 4; ++j) w[t][q][j] = __builtin_nontemporal_load(yr + 64 * j); } }
#pragma unroll
        for (int t = 0; t < 2; ++t) { const int m = m0 + t * NGW; f32x4* orow = (f32x4*)(dst + (size_t)m * D) + lane;
#pragma unroll
            for (int j = 0; j < 4; ++j) { { const unsigned lo_ = (unsigned)at[t][j], hi_ = (unsigned)(at[t][j] >> 32); v[t][j].x += pg8::bf_lo(lo_); v[t][j].y += pg8::bf_hi(lo_); v[t][j].z += pg8::bf_lo(hi_); v[t][j].w += pg8::bf_hi(hi_); }
#pragma unroll
                for (int q = 0; q < 4; ++q) { const f32x2 a = __builtin_amdgcn_cvt_pk_f32_fp8((int)w[t][q][j], false), b = __builtin_amdgcn_cvt_pk_f32_fp8((int)w[t][q][j], true);
                    v[t][j].x += a.x; v[t][j].y += a.y; v[t][j].z += b.x; v[t][j].w += b.y; }
                __builtin_nontemporal_store(v[t][j], orow + 64 * j); } }
    }
}
struct Args { const float* in[16]; float* out; unsigned char* ws; int ph_lo, ph_hi, li, pad; };
__global__ void __launch_bounds__(NWAVES * 64, 2) moe_block_fwd(Args args) {
    extern __shared__ __attribute__((aligned(16))) unsigned char lds[];
    Frame F;
    F.lds = (LAS unsigned char*)lds;
    F.MISC = (volatile LAS unsigned*)(F.lds + MISC_OFF);
    F.wave = __builtin_amdgcn_readfirstlane((int)threadIdx.x >> 6);
    F.G = gridDim.x; { const int bx = blockIdx.x; F.vcu = (F.G % 8 == 0) ? (bx % 8) * (F.G / 8) + bx / 8 : bx; }
    F.ws = args.ws; F.ctl = (gu32*)(args.ws + WS_CTL); F.out = args.out;
    for (int u = F.wave * 64 + pg8::lane_now(); u < (LDS_BYTES - LDSCTL_OFF) / 4; u += NWAVES * 64) ((LAS unsigned*)(F.lds + LDSCTL_OFF))[u] = 0u;
    __syncthreads();
    XcdBarrier bar; bar.bar = (unsigned*)(F.ctl + CW_BAR); bar.x = 0; bar.st = nullptr;
    if (N_LAUNCHES != PER_PHASE) bar = xcd_barrier_post((unsigned*)(F.ctl + CW_BAR), F.MISC + 8, F.wave == 0 && pg8::lane_now() == 0);
#define GRID_BAR(seam) do { if (N_LAUNCHES == PER_PHASE) { if (F.wave == 0 && pg8::lane_now() == 0) __hip_atomic_store(F.ctl + CW_TMO, 0xBADBA0u | (unsigned)(seam), RLX_AGENT); } else { xcd_barrier(bar, F.wave == 0 && pg8::lane_now() == 0); } } while (0)
    const int lo = args.ph_lo, hi = args.ph_hi;
#define IN(k) (lo <= (k) && (k) < hi)
#define BOTH(k) (IN(k) && IN((k) + 1))
#define WIN ((bf16*)(F.ws + WS_WIN))
#define PA ((bf16*)(F.ws + WS_PA))
#define WO ((bf16*)(F.ws + WS_WO))
#define WGU ((bf16*)(F.ws + WS_WGU))
#define WD ((bf16*)(F.ws + WS_WD))
#define XN ((bf16*)(F.ws + WS_XN))
#define YA ((bf16*)(F.ws + WS_YA))
#define YB YA
#define MG ((bf16*)(F.ws + WS_MG))
#define PROJ ((bf16*)(F.ws + WS_PROJ))
#define ACT PROJ
#define YBUF ((bf16*)(F.ws + WS_YBUF))
    const LAS int* tiletab = (const LAS int*)(F.lds + TILETAB_OFF); const LAS int* cntl = (const LAS int*)(F.lds + CNT_OFF);
    LAS unsigned* rowtab = (LAS unsigned*)(F.lds + ROWTAB_OFF);

#ifndef PROBE_REP
#define PROBE_REP -1
#endif
#define REPS(k) ((PROBE_REP == (k)) ? 2 : 1)
    if (IN(0)) { for (int rep = 0; rep < REPS(0); ++rep) p0_prologue(F, args.in[0], args.in[1], args.in[2], args.in[6], args.in[7], args.in[8], args.in[12], args.in[14], args.in[9], args.in[10]); if (BOTH(0)) GRID_BAR(0); }
    if (IN(1)) for (int rep = 0; rep < REPS(1); ++rep) {
        { pg8::Gemm g{F.ws, (unsigned)WS_XN, (unsigned)WS_WIN, D, D}; pg8::StaticOrder S; S.init(M, GA_COL, F.G, (int)blockIdx.x);
          pg8::EpiBf16 E{PROJ, INW, 1.0f, 0};
          pg8::WdRider R{args.in[14], F.ws + WS_WD, 0};
          pg8::gemm_phase<pg8::EpiBf16, pg8::StaticOrder, true, false, false, pg8::NoHook, pg8::WdRider>(F.lds + RING_OFF, g, S, E, F.wave, pg8::NoHook(), R); }
        { pg8::Gemm g{F.ws, (unsigned)WS_XN8, (unsigned)WS_WIN8, D / 2, D / 2}; pg8::StaticOrder S;
          if (F.G == 256) { const int bx = (int)blockIdx.x; if (bx < 128) S.init_uneven(M, INW - GA_COL, 128, bx, 640, 3); else S.init_uneven(M, INW - GA_COL, 128, bx - 128, 0, 5); }
          else S.init(M, INW - GA_COL, F.G, (int)blockIdx.x);
          pg8::EpiBf16 E{PROJ + GA_COL, INW, 0.03125f, 1};
          pg8::WdRider R{args.in[14], F.ws + WS_WD, 1152};
          pg8::gemm_phase<pg8::EpiBf16, pg8::StaticOrder, true, false, true, pg8::NoHook, pg8::WdRider>(F.lds + RING_OFF, g, S, E, F.wave, pg8::NoHook(), R); }
        if (BOTH(1) && rep == REPS(1) - 1) GRID_BAR(1);
    }
    if (IN(2)) for (int rep = 0; rep < REPS(2); ++rep) {
        att::attn_phase((__attribute__((address_space(3))) char*)(F.lds + RING_OFF), PROJ, YA, YB, args.in[3], args.in[4], args.in[5], args.in[12], F.ws + WS_WGU, F.ws, (unsigned)WS_PROJ, F.vcu, F.G, F.wave, pg8::lane_now());
        if (BOTH(2) && rep == REPS(2) - 1) GRID_BAR(2);
    }
    if (IN(3)) for (int rep = 0; rep < REPS(3); ++rep) {
        pg8::Gemm g{F.ws, (unsigned)WS_YA, (unsigned)WS_PA, D, D}; pg8::StaticOrder S; S.init(M, D, F.G, (int)blockIdx.x);
        pg8::HookGateRatio H{PROJ + GA_COL, PROJ + GB_COL, INW};
        pg8::EpiGateFinal E{MG, D, PROJ + GB_COL, INW};
        pg8::gemm_phase<pg8::EpiGateFinal, pg8::StaticOrder, true, false, false, pg8::HookGateRatio>(F.lds + RING_OFF, g, S, E, F.wave, H);
        if (BOTH(3) && rep == REPS(3) - 1) GRID_BAR(3);
    }
    if (IN(4)) for (int rep = 0; rep < REPS(4); ++rep) {
        pg8::Gemm g{F.ws, (unsigned)WS_MG, (unsigned)WS_WO, D, D}; pg8::StaticOrder S; S.init(M, D, F.G, (int)blockIdx.x);
        pg8::EpiBf16D E{YA, D};
        pg8::gemm_phase<pg8::EpiBf16D, pg8::StaticOrder, true, false>(F.lds + RING_OFF, g, S, E, F.wave);
        if (BOTH(4) && rep == REPS(4) - 1) GRID_BAR(4);
    }
    if (IN(5)) { if (REPS(5) == 2) p5_route(F, args.in[0], args.in[9], args.in[11], args.in[14], true); p5_route(F, args.in[0], args.in[9], args.in[11], args.in[14]); if (BOTH(5)) GRID_BAR(5); }
    if (IN(6)) for (int rep = 0; rep < REPS(6); ++rep) {
        const int nM = moe_tables(F);
        pg8::GroupOrder S; S.init(nM, 2048 / 256, F.G, (int)blockIdx.x); S.tiletab = tiletab; S.rowtab = rowtab; S.bstride = 2048u * 1024u; S.gather = true;
        { const int* laid = (const int*)(F.ws + WS_LAID); pg8::Unit u;
          const int ln = pg8::lane_now();
          for (int i = F.wave; i < 18 && S.next(i, u); i += 8) { const int tt = tiletab[u.pm], e = tt >> 16, lr0 = (tt & 0xffff) * 256 + ln, ce = cntl[e]; int aid[4];
#pragma unroll
              for (int k = 0; k < 4; ++k) { const int lrow = lr0 + 64 * k; aid[k] = laid[(size_t)e * ECAP + (lrow < ce ? lrow : 0)]; }
#pragma unroll
              for (int k = 0; k < 4; ++k) rowtab[i * 256 + 64 * k + ln] = (unsigned)(aid[k] >> 2) * 1024u; }
          __syncthreads(); }
        pg8::Gemm g{F.ws, (unsigned)WS_XN, (unsigned)WS_WGU, D / 2, D / 2};
        pg8::EpiSwiglu E{(unsigned char*)ACT, args.in[13], (const float*)(F.ws + WS_LRS), tiletab, cntl};
        pg8::gemm_phase<pg8::EpiSwiglu, pg8::GroupOrder, true, true, true>(F.lds + RING_OFF, g, S, E, F.wave);
        if (BOTH(6) && rep == REPS(6) - 1) GRID_BAR(6);
    }
    if (IN(7)) for (int rep = 0; rep < REPS(7); ++rep) {
        const int nM = moe_tables(F);
        pg8::GroupOrder S; S.init(nM, 1024 / 256, F.G, (int)blockIdx.x); S.tiletab = tiletab; S.rowtab = nullptr; S.bstride = 1024u * 1024u; S.gather = false;
        pg8::Gemm g{F.ws, (unsigned)WS_PROJ, (unsigned)WS_WD, DFF / 2, DFF / 2};
        pg8::EpiDown E{(unsigned char*)YBUF, args.in[15], (const int*)(F.ws + WS_LAID), (const float*)(F.ws + WS_LGATE), tiletab, cntl};
        pg8::gemm_phase<pg8::EpiDown, pg8::GroupOrder, true, false, true, pg8::NoHook, pg8::NoRider, true>(F.lds + RING_OFF, g, S, E, F.wave);
        if (BOTH(7) && rep == REPS(7) - 1) GRID_BAR(7);
    }
    if (IN(8)) { if (REPS(8) == 2) p8_combine(F, args.in[0], (float*)(F.ws + WS_MG)); p8_combine(F, args.in[0], F.out); }
#undef IN
#undef BOTH
}

extern "C" void kernel_launch(void* const* d_in, const int* in_sizes, int n_in, void* d_out, int out_size, void* d_ws, size_t ws_size, hipStream_t stream) {
    static int grid = 0;
    if (grid == 0) {
        if (n_in != 16 || in_sizes[0] != M * D || out_size != M * D || ws_size < WS_END) { fprintf(stderr, "kernel_launch: unexpected shapes (n_in %d, in0 %d, out %d, ws %zu); nothing launched\n", n_in, n_in > 0 ? in_sizes[0] : -1, out_size, ws_size); grid = -1; return; }
        int dev = 0, cus = 0, per_cu = 0;
        if (hipGetDevice(&dev) != hipSuccess || hipDeviceGetAttribute(&cus, hipDeviceAttributeMultiprocessorCount, dev) != hipSuccess) { fprintf(stderr, "kernel_launch: device query failed\n"); grid = -1; return; }
        if (hipFuncSetAttribute((const void*)moe_block_fwd, hipFuncAttributeMaxDynamicSharedMemorySize, LDS_BYTES) != hipSuccess) { fprintf(stderr, "kernel_launch: hipFuncSetAttribute failed\n"); grid = -1; return; }
        if (hipOccupancyMaxActiveBlocksPerMultiprocessor(&per_cu, (const void*)moe_block_fwd, NWAVES * 64, LDS_BYTES) != hipSuccess || per_cu < 1)
            fprintf(stderr, "kernel_launch: note: occupancy query reports %d workgroups per CU\n", per_cu);
        (void)hipGetLastError();
        grid = cus;
        if (grid < 160 || grid > 1024) { fprintf(stderr, "kernel_launch: unsupported CU count %d\n", grid); grid = -1; return; }
    }
    if (grid < 0) return;
    if (hipMemsetAsync((char*)d_ws + WS_CTL, 0, CTL_ZERO_BYTES, stream) != hipSuccess) { fprintf(stderr, "kernel_launch: memset failed\n"); return; }
    Args a{};
    for (int i = 0; i < 16; ++i) a.in[i] = (const float*)d_in[i];
    a.out = (float*)d_out; a.ws = (unsigned char*)d_ws;
    for (int li = 0; li < N_LAUNCHES; ++li) {
        a.ph_lo = (N_LAUNCHES == PER_PHASE) ? li : 0; a.ph_hi = (N_LAUNCHES == PER_PHASE) ? li + 1 : PER_PHASE; a.li = li;
        hipLaunchKernelGGL(moe_block_fwd, dim3(grid), dim3(NWAVES * 64), LDS_BYTES, stream, a);
        const hipError_t le = hipPeekAtLastError();
        if (le != hipSuccess) { fprintf(stderr, "kernel_launch: launch %d failed: %s\n", li, hipGetErrorName(le)); break; }
    }
}
```

```cpp
#include <hip/hip_runtime.h>
#include <cstdio>
#include <cstdint>

#ifndef MK_N_LAUNCHES
#define MK_N_LAUNCHES 1
#endif
#ifndef PG8_DMA_IN_MMA
#define PG8_DMA_IN_MMA 0
#endif

namespace pg8 {
#define PG8_LAS __attribute__((address_space(3)))
__device__ __forceinline__ int lane_now() { int l; asm volatile("v_mbcnt_lo_u32_b32 %0, -1, 0\n\tv_mbcnt_hi_u32_b32 %0, -1, %0" : "=v"(l)); return l; }
typedef unsigned short bf16_t;
typedef short bf16x8 __attribute__((ext_vector_type(8)));
typedef float f32x4 __attribute__((ext_vector_type(4)));
typedef unsigned u32x4 __attribute__((ext_vector_type(4)));
constexpr int BM = 256, BK = 64, HALF = 128, HTB = HALF * BK * 2, STAGE_BYTES = 8 * HTB, NXCD = 8;

__host__ __device__ __forceinline__ int lds_byte(int r, int c) { const int st = (r >> 4) * 2 + (c >> 5), rr = r & 15, cc = c & 31, ob = rr * 64 + cc * 2; return st * 1024 + (ob ^ (((ob >> 9) & 1) << 5)); }
__host__ __device__ __forceinline__ void stage_rc(int b, int& R, int& C) { const int st = b / 1024, sb = b % 1024, swz = sb ^ (((sb >> 9) & 1) << 5); R = (st >> 1) * 16 + swz / 64; C = (st & 1) * 32 + (swz % 64) / 2; }
__host__ __device__ __forceinline__ int perm32(int rho) { const int n = rho >> 4, i = rho & 15; return 8 * (i >> 2) + 4 * n + (i & 3); }

struct Unit { int pm, pn; };
struct Gemm { const void* base; unsigned a_off, b_off; int lda; int K; };

struct StaticOrder {
    const PG8_LAS int* cache = nullptr;
    int nM, nN, nwg, G, c, base, nmine, WGM;
    __device__ void init(int M, int N, int G_, int c_, int wgm = 4) { nM = M / BM; nN = N / BM; nwg = nM * nN; G = G_; c = c_; base = 0; nmine = 0x7fffffff; WGM = wgm; }
    __device__ void init_uneven(int M, int N, int stride_, int c_, int base_, int nmine_, int wgm = 4) { nM = M / BM; nN = N / BM; nwg = nM * nN; G = stride_; c = c_; base = base_; nmine = nmine_; WGM = wgm; }
    __device__ __forceinline__ void fill(PG8_LAS int* tab, int lane, bool writer) { cache = nullptr; Unit u; if (writer && lane < 32) tab[lane] = next(lane, u) ? ((u.pm << 8) | u.pn) : -1; cache = tab; }
    __device__ __forceinline__ bool next(int i, Unit& u) const {
        if (cache) { if (i >= 32) return false; const int v = __builtin_amdgcn_readfirstlane(cache[i]); if (v < 0) return false; u.pm = v >> 8; u.pn = v & 255; return true; }
        const long L = (long)base + (long)i * G + c; if (i >= nmine || L >= nwg) return false;
        int wgid = (int)L; { const int q = nwg / NXCD, r = nwg % NXCD, xcd = wgid % NXCD, off = wgid / NXCD; wgid = (xcd < r ? xcd * (q + 1) : r * (q + 1) + (xcd - r) * q) + off; }
        const int nig = WGM * nN, gid = wgid / nig, fm = gid * WGM, gsz = (nM - fm) < WGM ? (nM - fm) : WGM;
        u.pm = fm + ((wgid % nig) % gsz); u.pn = (wgid % nig) / gsz; return true;
    }
    __device__ __forceinline__ long lin(int i) const { return (long)base + (long)i * G + c; }
    __device__ __forceinline__ unsigned a_ptr(const Gemm& g, const Unit& u) const { return g.a_off + (unsigned)u.pm * (unsigned)(BM * 2) * (unsigned)g.lda; }
    __device__ __forceinline__ unsigned b_ptr(const Gemm& g, const Unit& u) const { return g.b_off + (unsigned)u.pn * (unsigned)(BM * 2) * (unsigned)g.K; }
    __device__ __forceinline__ unsigned row_off(int, int) const { return 0u; }
};

struct GroupOrder {
    const PG8_LAS int* cache = nullptr;
    int nM, nN, nwg, G, c, WGM, ibase, nmine;
    const PG8_LAS int* tiletab;
    const PG8_LAS unsigned* rowtab;
    unsigned bstride;
    bool gather;
    __device__ void init(int nM_, int nN_, int G_, int c_, int wgm = 4) { nM = nM_; nN = nN_; nwg = nM * nN; G = G_; c = c_; WGM = wgm; ibase = 0; nmine = 0x7fffffff; }
    __device__ __forceinline__ void fill(PG8_LAS int* tab, int lane, bool writer) { cache = nullptr; const int ib = ibase, nm = nmine; ibase = 0; nmine = 0x7fffffff; Unit u; if (writer && lane < 32) tab[lane] = next(lane, u) ? ((u.pm << 8) | u.pn) : -1; ibase = ib; nmine = nm; cache = tab; }
    __device__ __forceinline__ bool next(int i, Unit& u) const {
        if (cache) { if (i >= nmine || ibase + i >= 32) return false; const int v = __builtin_amdgcn_readfirstlane(cache[ibase + i]); if (v < 0) return false; u.pm = v >> 8; u.pn = v & 255; return true; }
        const long L = (long)(ibase + i) * G + c; if (i >= nmine || L >= nwg) return false;
        int wgid = (int)L; { const int q = nwg / NXCD, r = nwg % NXCD, xcd = wgid % NXCD, off = wgid / NXCD; wgid = (xcd < r ? xcd * (q + 1) : r * (q + 1) + (xcd - r) * q) + off; }
        const int nig = WGM * nN, gid = wgid / nig, fm = gid * WGM, gsz = (nM - fm) < WGM ? (nM - fm) : WGM;
        u.pm = fm + ((wgid % nig) % gsz); u.pn = (wgid % nig) / gsz; return true;
    }
    __device__ __forceinline__ unsigned a_ptr(const Gemm& g, const Unit& u) const { return gather ? g.a_off : g.a_off + (unsigned)u.pm * (unsigned)(BM * 2) * (unsigned)g.lda; }
    __device__ __forceinline__ unsigned b_ptr(const Gemm& g, const Unit& u) const { const int e = __builtin_amdgcn_readfirstlane(tiletab[u.pm]) >> 16; return g.b_off + (unsigned)e * bstride + (unsigned)u.pn * (unsigned)(BM * 2) * (unsigned)g.K; }
    __device__ __forceinline__ unsigned row_off(int ui, int r) const { return rowtab[(ibase + ui) * 256 + r]; }
    __device__ __forceinline__ long lin(int i) const { return (long)(ibase + i) * G + c; }
};
struct ListOrder {
    const PG8_LAS int* list; int n, nA; const PG8_LAS int* tiletab; unsigned bstride; unsigned* flag2; unsigned nx2;
    __device__ __forceinline__ bool next(int i, Unit& u) const {
        if (i >= n) return false;
        if (i == nA) { unsigned sp = 0; while (__hip_atomic_load(flag2, __ATOMIC_RELAXED, __HIP_MEMORY_SCOPE_AGENT) != nx2) { __builtin_amdgcn_s_sleep(1); if (++sp > (1u << 24)) break; }
            __builtin_amdgcn_fence(__ATOMIC_ACQUIRE, "agent"); }
        const int v = list[i]; u.pm = v >> 4; u.pn = v & 15; return true;
    }
    __device__ __forceinline__ unsigned a_ptr(const Gemm& g, const Unit& u) const { return g.a_off + (unsigned)u.pm * (unsigned)(BM * 2) * (unsigned)g.lda; }
    __device__ __forceinline__ unsigned b_ptr(const Gemm& g, const Unit& u) const { const int e = __builtin_amdgcn_readfirstlane(tiletab[u.pm]) >> 16; return g.b_off + (unsigned)e * bstride + (unsigned)u.pn * (unsigned)(BM * 2) * (unsigned)g.K; }
    __device__ __forceinline__ unsigned row_off(int, int) const { return 0u; }
    __device__ __forceinline__ long lin(int i) const { return i; }
};

__device__ __forceinline__ unsigned cvt_pk_bf16(float lo, float hi) { typedef float f2 __attribute__((ext_vector_type(2))); typedef __bf16 b2 __attribute__((ext_vector_type(2))); f2 v = {lo, hi}; b2 b = __builtin_convertvector(v, b2); return __builtin_bit_cast(unsigned, b); }
__device__ __forceinline__ float bf_lo(unsigned u) { return __uint_as_float(u << 16); }
__device__ __forceinline__ float bf_hi(unsigned u) { return __uint_as_float(u & 0xffff0000u); }
__device__ __forceinline__ float sigmoid_f(float x) { return __builtin_amdgcn_rcpf(1.0f + __builtin_amdgcn_exp2f(-1.4426950408889634f * x)); }

__device__ __forceinline__ float clamp448(float x) { return __builtin_amdgcn_fmed3f(x, -448.0f, 448.0f); }
__device__ __forceinline__ unsigned pk4_fp8(float a, float b, float c, float d) {
    int r = __builtin_amdgcn_cvt_pk_fp8_f32(clamp448(a), clamp448(b), 0, false); r = __builtin_amdgcn_cvt_pk_fp8_f32(clamp448(c), clamp448(d), r, true); return (unsigned)r; }
typedef float f32x2 __attribute__((ext_vector_type(2)));
__device__ __forceinline__ unsigned pk4_fp8_nc(f32x2 a, f32x2 b) { int r = __builtin_amdgcn_cvt_pk_fp8_f32(a.x, a.y, 0, false); r = __builtin_amdgcn_cvt_pk_fp8_f32(b.x, b.y, r, true); return (unsigned)r; }
__device__ __forceinline__ f32x4 sigmoid4_scaled(f32x4 a, float ks) {
    constexpr float AMAX = 30.0f * 1.4426950408889634f; f32x4 s;
#pragma unroll
    for (int q = 0; q < 4; ++q) s[q] = __builtin_amdgcn_rcpf(1.0f + __builtin_amdgcn_exp2f(fminf(a[q] * ks, AMAX)));
    return s;
}
constexpr unsigned EPIMETA = 152576u, EPIMETA_IMG = 3072u;
__device__ __forceinline__ void meta_dma(const void* src, unsigned byte_off, unsigned lds_addr, int lane) {
    const __amdgpu_buffer_rsrc_t r = __builtin_amdgcn_make_buffer_rsrc((void*)src, 0, 0x7fffffff, 0x00020000);
    __builtin_amdgcn_raw_ptr_buffer_load_lds(r, (PG8_LAS unsigned*)lds_addr, 4, lane * 4, (int)byte_off, 0, 0);
}
__device__ __forceinline__ unsigned pk4_fp8_x32(float a, float b, float c, float d) {
    unsigned r; const float sc = 0.03125f;
    a = __builtin_amdgcn_fmed3f(a, -14.0f, 14.0f); b = __builtin_amdgcn_fmed3f(b, -14.0f, 14.0f); c = __builtin_amdgcn_fmed3f(c, -14.0f, 14.0f); d = __builtin_amdgcn_fmed3f(d, -14.0f, 14.0f);
    asm("v_cvt_scalef32_pk_fp8_f32 %0, %1, %2, %3" : "=v"(r) : "v"(a), "v"(b), "s"(sc));
    asm("v_cvt_scalef32_pk_fp8_f32 %0, %1, %2, %3 op_sel:[0,0,0,1]" : "+v"(r) : "v"(c), "v"(d), "s"(sc));
    return r; }
struct EpiBf16 {
    static constexpr bool PERM = true; static constexpr bool META = false;
    bf16_t* O; int ldc; float scale; int sig;
    static constexpr unsigned RING_END = 131072u;
    __device__ __forceinline__ void half(int ai, const f32x4 (&acc)[2][2][4][2], const Unit& u, int wr, int wc, int fr, int fq) const {
        PG8_LAS unsigned char* t = (PG8_LAS unsigned char*)(RING_END + (unsigned)(wr * 4 + wc) * 2048u); const int lane = fq * 16 + fr;
#pragma unroll
        for (int m = 0; m < 4; ++m) {
#pragma unroll
            for (int bj = 0; bj < 2; ++bj) { f32x4 v0 = acc[ai][bj][m][0] * scale, v1 = acc[ai][bj][m][1] * scale;
                if (sig) { const float ks = -1.4426950408889634f * scale; v0 = sigmoid4_scaled(acc[ai][bj][m][0], ks); v1 = sigmoid4_scaled(acc[ai][bj][m][1], ks); }
                u32x4 w; w.x = cvt_pk_bf16(v0[0], v0[1]); w.y = cvt_pk_bf16(v0[2], v0[3]); w.z = cvt_pk_bf16(v1[0], v1[1]); w.w = cvt_pk_bf16(v1[2], v1[3]);
                *(PG8_LAS u32x4*)(t + fr * 128 + bj * 64 + fq * 16) = w; }
            bf16_t* base = O + (size_t)(u.pm * BM + ai * HALF + wr * 64 + m * 16) * ldc + u.pn * BM + wc * 64;
#pragma unroll
            for (int p = 0; p < 2; ++p) { const int row = 8 * p + (lane >> 3); const u32x4 w = *(const PG8_LAS u32x4*)(t + row * 128 + (lane & 7) * 16);
                __builtin_nontemporal_store(w, (u32x4*)(base + (size_t)row * ldc + 8 * (lane & 7))); }
        }
    }
    __device__ __forceinline__ void operator()(const f32x4 (&acc)[2][2][4][2], const Unit& u, int wr, int wc, int fr, int fq) const { half(0, acc, u, wr, wc, fr, fq); half(1, acc, u, wr, wc, fr, fq); }
};
struct EpiBf16D {
    static constexpr bool PERM = true; static constexpr bool META = false;
    bf16_t* O; int ldc;
    __device__ __forceinline__ void operator()(const f32x4 (&acc)[2][2][4][2], const Unit& u, int wr, int wc, int fr, int fq) const {
        const int row0 = u.pm * BM + wr * 64 + fr, col0 = u.pn * BM + wc * 32 + 8 * fq;
#pragma unroll
        for (int ai = 0; ai < 2; ++ai)
#pragma unroll
            for (int m = 0; m < 4; ++m) { bf16_t* rowp = O + (size_t)(row0 + ai * HALF + m * 16) * ldc + col0;
#pragma unroll
                for (int bj = 0; bj < 2; ++bj) { const f32x4 v0 = acc[ai][bj][m][0], v1 = acc[ai][bj][m][1];
                    u32x4 w; w.x = cvt_pk_bf16(v0[0], v0[1]); w.y = cvt_pk_bf16(v0[2], v0[3]); w.z = cvt_pk_bf16(v1[0], v1[1]); w.w = cvt_pk_bf16(v1[2], v1[3]);
                    *(u32x4*)(rowp + bj * HALF) = w; } }
    }
};
__device__ __forceinline__ float gate_e(float g) { return __builtin_amdgcn_exp2f(-1.4426950408889634f * g); }
struct HookGateRatio {
    static constexpr bool ENABLED = true;
    const bf16_t* Ga; const bf16_t* Gb; int ldg;
    __device__ __forceinline__ void operator()(f32x4 (&acc)[2][2][4][2], const Unit& u, int wr, int wc, int fr, int fq) const {
        const int row0 = u.pm * BM + wr * 64 + fr, col0 = u.pn * BM + wc * 32 + 8 * fq;
#pragma unroll
        for (int ai = 0; ai < 2; ++ai)
#pragma unroll
            for (int m = 0; m < 4; ++m) { const size_t row = (size_t)(row0 + ai * HALF + m * 16);
#pragma unroll
                for (int bj = 0; bj < 2; ++bj) { const u32x4 ga = *(const u32x4*)(Ga + row * ldg + col0 + bj * HALF), gb = *(const u32x4*)(Gb + row * ldg + col0 + bj * HALF);
#pragma unroll
                    for (int q = 0; q < 4; ++q) { const float r0 = bf_lo(ga[q]) * __builtin_amdgcn_rcpf(bf_lo(gb[q])), r1 = bf_hi(ga[q]) * __builtin_amdgcn_rcpf(bf_hi(gb[q]));
                        acc[ai][bj][m][q >> 1][2 * (q & 1)] *= r0; acc[ai][bj][m][q >> 1][2 * (q & 1) + 1] *= r1; } } }
    }
};
struct EpiGateFinal {
    static constexpr bool PERM = true; static constexpr bool META = false;
    bf16_t* O; int ldc; const bf16_t* Gb; int ldg;
    __device__ __forceinline__ void operator()(const f32x4 (&acc)[2][2][4][2], const Unit& u, int wr, int wc, int fr, int fq) const {
        const int row0 = u.pm * BM + wr * 64 + fr, col0 = u.pn * BM + wc * 32 + 8 * fq;
#pragma unroll
        for (int ai = 0; ai < 2; ++ai)
#pragma unroll
            for (int m = 0; m < 4; ++m) { const size_t row = (size_t)(row0 + ai * HALF + m * 16);
#pragma unroll
                for (int bj = 0; bj < 2; ++bj) { const u32x4 gb = *(const u32x4*)(Gb + row * ldg + col0 + bj * HALF);
                    float r[8];
#pragma unroll
                    for (int q = 0; q < 4; ++q) { r[2 * q] = acc[ai][bj][m][q >> 1][2 * (q & 1)] * bf_lo(gb[q]); r[2 * q + 1] = acc[ai][bj][m][q >> 1][2 * (q & 1) + 1] * bf_hi(gb[q]); }
                    u32x4 w; w.x = cvt_pk_bf16(r[0], r[1]); w.y = cvt_pk_bf16(r[2], r[3]); w.z = cvt_pk_bf16(r[4], r[5]); w.w = cvt_pk_bf16(r[6], r[7]);
                    *(u32x4*)(O + row * ldc + col0 + bj * HALF) = w; } }
    }
};
struct EpiResF32 {
    static constexpr bool PERM = false; static constexpr bool META = false;
    const float* base; float* out; int ldc;
    __device__ __forceinline__ void operator()(const f32x4 (&acc)[2][2][4][2], const Unit& u, int wr, int wc, int fr, int fq) const {
        const int col0 = u.pn * BM + wc * 32 + 4 * fq;
        f32x4 b0[8], b1[8];
#define ERF_OFF(ch, t) ((size_t)(u.pm * BM + ((ch) >> 1) * HALF + wr * 64 + (2 * ((ch) & 1) + ((t) >> 2)) * 16 + fr) * ldc + col0 + (((t) >> 1) & 1) * HALF + ((t) & 1) * 16)
#define ERF_LOAD(B, ch) do { _Pragma("unroll") for (int t = 0; t < 8; ++t) B[t] = *(const f32x4*)(base + ERF_OFF(ch, t)); } while (0)
#define ERF_STORE(B, ch) do { _Pragma("unroll") for (int t = 0; t < 8; ++t) *(f32x4*)(out + ERF_OFF(ch, t)) = B[t] + acc[(ch) >> 1][((t) >> 1) & 1][2 * ((ch) & 1) + ((t) >> 2)][(t) & 1]; } while (0)
        ERF_LOAD(b0, 0); ERF_LOAD(b1, 1); ERF_STORE(b0, 0); ERF_LOAD(b0, 2); ERF_STORE(b1, 1); ERF_LOAD(b1, 3); ERF_STORE(b0, 2); ERF_STORE(b1, 3);
#undef ERF_OFF
#undef ERF_LOAD
#undef ERF_STORE
    }
};
struct EpiSwiglu {
    static constexpr bool PERM = true; static constexpr bool META = true;
    unsigned char* ACT; const float* bgu; const float* rs_list; const PG8_LAS int* tiletab; const PG8_LAS int* cnt;
    __device__ __forceinline__ void meta_issue(const Unit& u, int buf, int wid, int lane) const {
        const int tt = __builtin_amdgcn_readfirstlane(tiletab[u.pm]), e = tt >> 16, lt = tt & 0xffff; const unsigned dst = EPIMETA + (unsigned)buf * EPIMETA_IMG + (unsigned)wid * 256u;
        if (wid < 4) meta_dma(rs_list, (unsigned)(e * 32768 + lt * 256 + wid * 64) * 4u, dst, lane);
        else meta_dma(bgu, (unsigned)(e * 2048 + (wid >> 1 & 1) * 1024 + u.pn * HALF + (wid & 1) * 64) * 4u, dst, lane);
    }
    __device__ __forceinline__ void run(const f32x4 (&acc)[2][2][4][2], const Unit& u, int wr, int wc, int fr, int fq, int buf) const { run_range<0, 2>(acc, u, wr, wc, fr, fq, buf); }
    template <int A0, int A1>
    __device__ __forceinline__ void run_range(const f32x4 (&acc)[2][2][4][2], const Unit& u, int wr, int wc, int fr, int fq, int buf) const {
        const int tt = __builtin_amdgcn_readfirstlane(tiletab[u.pm]), e = tt >> 16, lt = tt & 0xffff, ce = __builtin_amdgcn_readfirstlane(cnt[e]);
        const PG8_LAS float* mf = (const PG8_LAS float*)(EPIMETA + (unsigned)buf * EPIMETA_IMG);
        const PG8_LAS float* bg = mf + 256 + wc * 32 + 8 * fq;
        const f32x4 bg0 = *(const PG8_LAS f32x4*)bg, bg1 = *(const PG8_LAS f32x4*)(bg + 4), bu0 = *(const PG8_LAS f32x4*)(bg + 128), bu1 = *(const PG8_LAS f32x4*)(bg + 132);
        const int lr0 = lt * 256 + wr * 64 + fr;
        constexpr float KE = -1.702f * 1.4426950408889634f, IKE = 1.0f / KE;
        float bgK[8], buI[8];
#pragma unroll
        for (int q = 0; q < 4; ++q) { bgK[q] = bg0[q] * KE; bgK[4 + q] = bg1[q] * KE; buI[q] = (bu0[q] + 1.0f) * IKE; buI[4 + q] = (bu1[q] + 1.0f) * IKE; }
#pragma unroll
        for (int ai = A0; ai < A1; ++ai)
#pragma unroll
            for (int m = 0; m < 4; ++m) { const int rl = ai * HALF + wr * 64 + m * 16 + fr;
                const int o_ = ai * HALF + m * 16; const float rv_ = mf[wr * 64 + fr + o_]; const float rs_ = (lr0 + o_ < ce) ? rv_ * 0.03125f : 0.f;
                const float rsK = rs_ * KE, rsI = rs_ * IKE;
                float r[8];
#pragma unroll
                for (int n = 0; n < 2; ++n)
#pragma unroll
                    for (int q = 0; q < 4; ++q) { float h = __builtin_fmaf(acc[ai][0][m][n][q], rsK, bgK[n * 4 + q]), v = __builtin_fmaf(acc[ai][1][m][n][q], rsI, buI[n * 4 + q]);
                        h = fmaxf(h, 7.0f * KE); v = __builtin_amdgcn_fmed3f(v, 8.0f * IKE, -6.0f * IKE);
                        const float rc = __builtin_amdgcn_rcpf(1.0f + __builtin_amdgcn_exp2f(h));
                        r[n * 4 + q] = (h * v) * rc; }
                typedef unsigned u32x2_t __attribute__((ext_vector_type(2)));
                u32x2_t w; w.x = pk4_fp8_nc((f32x2){r[0], r[1]}, (f32x2){r[2], r[3]}); w.y = pk4_fp8_nc((f32x2){r[4], r[5]}, (f32x2){r[6], r[7]});
                *(u32x2_t*)(ACT + (size_t)(u.pm * 16 + ai * 8 + wr * 4 + m) * 16384 + (u.pn * 4 + wc) * 512 + fr * 32 + fq * 8) = w; }
    }
};
struct EpiDown {
    static constexpr bool PERM = true; static constexpr bool META = true;
    unsigned char* Y; const float* bd; const int* aid_list; const float* gate_list; const PG8_LAS int* tiletab; const PG8_LAS int* cnt;
    __device__ __forceinline__ void meta_issue(const Unit& u, int buf, int wid, int lane) const {
        const int tt = __builtin_amdgcn_readfirstlane(tiletab[u.pm]), e = tt >> 16, lt = tt & 0xffff; const unsigned dst = EPIMETA + (unsigned)buf * EPIMETA_IMG + (unsigned)wid * 256u;
        if (wid < 4) { meta_dma(aid_list, (unsigned)(e * 32768 + lt * 256 + wid * 64) * 4u, dst, lane); meta_dma(bd, (unsigned)(e * 1024 + u.pn * BM + wid * 64) * 4u, dst + 2048u, lane); }
        (void)gate_list;
    }
    __device__ __forceinline__ void run(const f32x4 (&acc)[2][2][4][2], const Unit& u, int wr, int wc, int fr, int fq, int buf) const {
        const int tt = __builtin_amdgcn_readfirstlane(tiletab[u.pm]), e = tt >> 16, lt = tt & 0xffff, ce = __builtin_amdgcn_readfirstlane(cnt[e]);
        const int c0 = u.pn * BM + wc * 64 + 16 * fq; const int nv = ce - lt * 256;
        const PG8_LAS float* mf = (const PG8_LAS float*)(EPIMETA + (unsigned)buf * EPIMETA_IMG); const PG8_LAS float* bdp = mf + 512 + wc * 64 + 16 * fq;
        const f32x4 b00 = *(const PG8_LAS f32x4*)(bdp), b01 = *(const PG8_LAS f32x4*)(bdp + 4), b10 = *(const PG8_LAS f32x4*)(bdp + 8), b11 = *(const PG8_LAS f32x4*)(bdp + 12);
        unsigned aidv[2][4];
#pragma unroll
        for (int ai = 0; ai < 2; ++ai)
#pragma unroll
            for (int m = 0; m < 4; ++m) { const int rl = ai * HALF + wr * 64 + m * 16 + fr; const unsigned a_ = __float_as_uint(mf[rl]); const bool ok = rl < nv; aidv[ai][m] = ok ? a_ : 0u; }
#pragma unroll
        for (int ai = 0; ai < 2; ++ai)
#pragma unroll
            for (int m = 0; m < 4; ++m) { const int rl = ai * HALF + wr * 64 + m * 16 + fr;
                {
                    f32x4 v0, v1, v2, v3;
#pragma unroll
                    for (int q = 0; q < 4; ++q) { v0[q] = __builtin_fmaf(acc[ai][0][m][0][q], 0.03125f, b00[q]); v1[q] = __builtin_fmaf(acc[ai][0][m][1][q], 0.03125f, b01[q]);
                        v2[q] = __builtin_fmaf(acc[ai][1][m][0][q], 0.03125f, b10[q]); v3[q] = __builtin_fmaf(acc[ai][1][m][1][q], 0.03125f, b11[q]); }
                    u32x4 w; w.x = pk4_fp8(v0[0], v0[1], v0[2], v0[3]); w.y = pk4_fp8(v1[0], v1[1], v1[2], v1[3]); w.z = pk4_fp8(v2[0], v2[1], v2[2], v2[3]); w.w = pk4_fp8(v3[0], v3[1], v3[2], v3[3]);
                    if (rl < nv) *(u32x4*)(Y + aidv[ai][m] * 1024u + (unsigned)c0) = w; } }
    }
};

constexpr int WD_HALF_ITEMS = 32 * 16 * 32;
__device__ __forceinline__ void wd_half_load(f32x4 (&v)[8], const float* wd, int item, int lane) {
    const int e = item >> 9, q = item & 511, kb = q >> 5, nb = q & 31, g = lane >> 3, c = lane & 7;
    const float* W = wd + (size_t)e * 1024 * 1024 + (size_t)(64 * kb + 8 * g) * 1024 + 32 * nb + 4 * c;
#pragma unroll
    for (int i = 0; i < 8; ++i) v[i] = __builtin_nontemporal_load((const f32x4*)(W + (size_t)i * 1024));
}
__device__ __forceinline__ void wd_half_store(const f32x4 (&v)[8], unsigned char* WD8, int item, int lane) {
    typedef unsigned u32x2_t __attribute__((ext_vector_type(2)));
    const int e = item >> 9, q = item & 511, kb = q >> 5, nb = q & 31, g = lane >> 3, c = lane & 7;
#pragma unroll
    for (int j = 0; j < 4; ++j) { u32x2_t o;
        o.x = pk4_fp8(v[0][j] * 32.0f, v[1][j] * 32.0f, v[2][j] * 32.0f, v[3][j] * 32.0f); o.y = pk4_fp8(v[4][j] * 32.0f, v[5][j] * 32.0f, v[6][j] * 32.0f, v[7][j] * 32.0f);
        const int nn = 32 * nb + 4 * c + j, n = nn & 255, drow = (nn & ~255) + 128 * ((n >> 3) & 1) + 32 * (n >> 6) + 8 * ((n >> 4) & 3) + (n & 7);
        __builtin_nontemporal_store(o, (u32x2_t*)(WD8 + (size_t)e * 1024 * 1024 + (size_t)drow * 1024 + 64 * kb + 8 * g)); }
}
struct NoRider { static constexpr bool ENABLED = false; };
__device__ __forceinline__ void wd_quarter_load(f32x4 (&v)[4], const float* wd, int item, int qh, int lane) {
    const int e = item >> 9, q = item & 511, kb = q >> 5, nb = q & 31, g = lane >> 3, c = lane & 7;
    const float* W = wd + (size_t)e * 1024 * 1024 + (size_t)(64 * kb + 8 * g + 4 * qh) * 1024 + 32 * nb + 4 * c;
#pragma unroll
    for (int i = 0; i < 4; ++i) v[i] = __builtin_nontemporal_load((const f32x4*)(W + (size_t)i * 1024));
}
__device__ __forceinline__ void wd_quarter_store(const f32x4 (&v)[4], unsigned char* WD8, int item, int qh, int lane) {
    const int e = item >> 9, q = item & 511, kb = q >> 5, nb = q & 31, g = lane >> 3, c = lane & 7;
#pragma unroll
    for (int j = 0; j < 4; ++j) { const unsigned o = pk4_fp8_x32(v[0][j], v[1][j], v[2][j], v[3][j]);
        const int nn = 32 * nb + 4 * c + j, n = nn & 255, drow = (nn & ~255) + 128 * ((n >> 3) & 1) + 32 * (n >> 6) + 8 * ((n >> 4) & 3) + (n & 7);
        *(unsigned*)(WD8 + (size_t)e * 1024 * 1024 + (size_t)drow * 1024 + 64 * kb + 8 * g + 4 * qh) = o; }
}
struct WdRider { static constexpr bool ENABLED = true; static constexpr int NITEMS = WD_HALF_ITEMS; const float* wd; unsigned char* WD8; int slot_base;
    __device__ __forceinline__ void load4(f32x4 (&v)[4], int item, int qh, int lane) const { wd_quarter_load(v, wd, item, qh, lane); }
    __device__ __forceinline__ void store4(const f32x4 (&v)[4], int item, int qh, int lane) const { wd_quarter_store(v, WD8, item, qh, lane); }
    __device__ __forceinline__ void load(f32x4 (&v)[8], int item, int lane) const { wd_half_load(v, wd, item, lane); }
    __device__ __forceinline__ void store(const f32x4 (&v)[8], int item, int lane) const { wd_half_store(v, WD8, item, lane); } };
constexpr int GU_HALF_ITEMS = 2 * 32 * 8 * 64;
__device__ __forceinline__ void gu_half_load(f32x4 (&v)[8], const float* wgu, int h, int lane) {
    const int item = h >> 1, kh = h & 1, e = item >> 9, q = item & 511, kb = q >> 6, nb = q & 63, g = lane >> 3, c = lane & 7;
    const float* W = wgu + (size_t)e * 1024 * 2048 + (size_t)(128 * kb + 64 * kh + 8 * g) * 2048 + 32 * nb + 4 * c;
#pragma unroll
    for (int i = 0; i < 8; ++i) v[i] = __builtin_nontemporal_load((const f32x4*)(W + (size_t)i * 2048));
}
__device__ __forceinline__ void gu_half_store(const f32x4 (&v)[8], unsigned char* WGU8, int h, int lane) {
    typedef unsigned u32x2_t __attribute__((ext_vector_type(2)));
    const int item = h >> 1, kh = h & 1, e = item >> 9, q = item & 511, kb = q >> 6, nb = q & 63, g = lane >> 3, c = lane & 7, n0 = 32 * nb;
    const int c0 = n0 & 1023, drow0 = 256 * (c0 >> 7) + (n0 >= 1024 ? 128 : 0) + (c0 & 127);
    unsigned char* dst = WGU8 + (size_t)e * 2048 * 1024 + (size_t)(drow0 + 4 * c) * 1024 + 128 * kb + 64 * kh + 8 * g;
#pragma unroll
    for (int j = 0; j < 4; ++j) { u32x2_t o;
        o.x = pk4_fp8_x32(v[0][j], v[1][j], v[2][j], v[3][j]); o.y = pk4_fp8_x32(v[4][j], v[5][j], v[6][j], v[7][j]);
        __builtin_nontemporal_store(o, (u32x2_t*)(dst + (size_t)j * 1024)); }
}
struct GuRider { static constexpr bool ENABLED = true; static constexpr int NITEMS = GU_HALF_ITEMS; const float* wgu; unsigned char* WGU8; int slot_base;
    __device__ __forceinline__ void load(f32x4 (&v)[8], int item, int lane) const { gu_half_load(v, wgu, item, lane); }
    __device__ __forceinline__ void store(const f32x4 (&v)[8], int item, int lane) const { gu_half_store(v, WGU8, item, lane); } };
typedef int v4i_t __attribute__((ext_vector_type(4)));
typedef int v8i_t __attribute__((ext_vector_type(8)));
constexpr int FP8_SCALE_W = 0x7A7A7A7A;
constexpr int FP8_SCALE_A = 0x7F7F7F7F;
struct NoHook { static constexpr bool ENABLED = false; __device__ __forceinline__ void operator()(f32x4 (&)[2][2][4][2], const Unit&, int, int, int, int) const {} };
template <class Epi, class Sched, bool ALIGN_EPI, bool GATHER, bool FP8 = false, class Hook = NoHook, class Rider = NoRider, bool ABLK = false>
__device__ __forceinline__ void gemm_phase(PG8_LAS unsigned char* lds, const Gemm g, const Sched& S, const Epi& E, int wave_id, const Hook& H = Hook(), const Rider& R = Rider()) {
    const int lane = lane_now(), wid = wave_id, tid = wid * 64 + lane, wr = wid >> 2, wc = wid & 3, fr = lane & 15, fq = lane >> 4;
    const int K = g.K, nt = K / BK, lda = g.lda;
    unsigned voffB[2];
#pragma unroll
    for (int i = 0; i < 2; ++i) { int R, C; stage_rc(tid * 16 + i * 8192, R, C); const int Rb = Epi::PERM ? ((R & ~31) + perm32(R & 31)) : R;
        voffB[i] = (unsigned)(Rb * K + C) * 2u; }
#define PG8_RA(i) ({ int R_, C_; stage_rc(tid * 16 + (i) * 8192, R_, C_); R_; })
#define PG8_CA(i) ({ int R_, C_; stage_rc(tid * 16 + (i) * 8192, R_, C_); C_; })
    const __amdgpu_buffer_rsrc_t rsrc = __builtin_amdgcn_make_buffer_rsrc((void*)g.base, 0, 0x7fffffff, 0x00020000);
    const unsigned kstep = (unsigned)(BK * 2), kstepA = ABLK ? 2048u : kstep;
    const unsigned hstepB = (unsigned)(HALF * 2) * (unsigned)K;
    const unsigned ldsw = (unsigned)wid * 1024u;
    const int aoff = lds_byte(wr * 64 + fr, fq * 8), boff = lds_byte(wc * 32 + fr, fq * 8);
#define PG8_SA(b, h) (((b) * 2 + (h)) * HTB)
#define PG8_SB(b, h) ((4 + (b) * 2 + (h)) * HTB)
#define PG8_STAGE(bufoff, gbase, voff) do { _Pragma("unroll") for (int _i = 0; _i < 2; ++_i) \
        __builtin_amdgcn_raw_ptr_buffer_load_lds(rsrc, (PG8_LAS unsigned*)(lds + (bufoff) + ldsw + _i * 8192), 16, (int)(voff)[_i], (int)(gbase), 0, 0); } while (0)
#define PG8_LDA(dst, b, h) do { _Pragma("unroll") for (int m = 0; m < 4; ++m) { if constexpr (FP8) { const v4i_t lo_ = *(const PG8_LAS v4i_t*)(lds + PG8_SA(b, h) + aoff + m * 2048), hi_ = *(const PG8_LAS v4i_t*)(lds + PG8_SA(b, h) + aoff + m * 2048 + 1024); \
        dst##8[m] = __builtin_shufflevector(lo_, hi_, 0, 1, 2, 3, 4, 5, 6, 7); } else { _Pragma("unroll") for (int k = 0; k < 2; ++k) dst[m][k] = *(const PG8_LAS bf16x8*)(lds + PG8_SA(b, h) + aoff + m * 2048 + k * 1024); } } } while (0)
#define PG8_LDB(dst, b, h) do { _Pragma("unroll") for (int n = 0; n < 2; ++n) { if constexpr (FP8) { const v4i_t lo_ = *(const PG8_LAS v4i_t*)(lds + PG8_SB(b, h) + boff + n * 2048), hi_ = *(const PG8_LAS v4i_t*)(lds + PG8_SB(b, h) + boff + n * 2048 + 1024); \
        dst##8[n] = __builtin_shufflevector(lo_, hi_, 0, 1, 2, 3, 4, 5, 6, 7); } else { _Pragma("unroll") for (int k = 0; k < 2; ++k) dst[n][k] = *(const PG8_LAS bf16x8*)(lds + PG8_SB(b, h) + boff + n * 2048 + k * 1024); } } } while (0)
#define PG8_MMA(ai, bj, At, Bt) do { \
        if constexpr (FP8) { _Pragma("unroll") for (int m = 0; m < 4; ++m) _Pragma("unroll") for (int n = 0; n < 2; ++n) { \
            asm volatile("v_mfma_f32_16x16x128_f8f6f4 %0, %1, %2, %0" : "+v"(acc[ai][bj][m][n]) : "v"(Bt##8[n]), "v"(At##8[m])); } } \
        else { _Pragma("unroll") for (int m = 0; m < 4; ++m) _Pragma("unroll") for (int n = 0; n < 2; ++n) _Pragma("unroll") for (int k = 0; k < 2; ++k) \
            asm volatile("v_mfma_f32_16x16x32_bf16 %0, %1, %2, %0" : "+v"(acc[ai][bj][m][n]) : "v"(Bt[n][k]), "v"(At[m][k])); } \
        } while (0)
#define PG8_MMA0(ai, bj, At, Bt) do { \
        if constexpr (FP8) { _Pragma("unroll") for (int m = 0; m < 4; ++m) _Pragma("unroll") for (int n = 0; n < 2; ++n) { \
            asm volatile("v_mfma_f32_16x16x128_f8f6f4 %0, %1, %2, 0" : "=&v"(acc[ai][bj][m][n]) : "v"(Bt##8[n]), "v"(At##8[m])); } } \
        else { _Pragma("unroll") for (int m = 0; m < 4; ++m) _Pragma("unroll") for (int n = 0; n < 2; ++n) { \
            asm volatile("v_mfma_f32_16x16x32_bf16 %0, %1, %2, 0" : "=&v"(acc[ai][bj][m][n]) : "v"(Bt[n][0]), "v"(At[m][0])); \
            asm volatile("v_mfma_f32_16x16x32_bf16 %0, %1, %2, %0" : "+v"(acc[ai][bj][m][n]) : "v"(Bt[n][1]), "v"(At[m][1])); } } \
        } while (0)
#define PG8_WAIT_V(n) asm volatile("s_waitcnt vmcnt(" #n ")" ::: "memory")
#define PG8_WAIT_L(n) asm volatile("s_waitcnt lgkmcnt(" #n ")" ::: "memory")
#define PG8_BAR __builtin_amdgcn_s_barrier()
#define PG8_SCHED __builtin_amdgcn_sched_barrier(0)
    Unit cur, nxt; int ui = 0;
    if (!S.next(0, cur)) return;
    unsigned cvA[2][2];
    if constexpr (GATHER) {
#pragma unroll
        for (int h = 0; h < 2; ++h)
#pragma unroll
            for (int i = 0; i < 2; ++i) cvA[h][i] = S.row_off(0, h * HALF + PG8_RA(i)) + (unsigned)PG8_CA(i) * 2u;
    } else {
#pragma unroll
        for (int i = 0; i < 2; ++i) { const int R_ = PG8_RA(i), cb_ = PG8_CA(i) * 2;
            cvA[0][i] = ABLK ? (unsigned)((R_ >> 4) * 32 * lda + (cb_ >> 5) * 512 + (R_ & 15) * 32 + (cb_ & 31)) : (unsigned)(R_ * lda + PG8_CA(i)) * 2u; cvA[1][i] = cvA[0][i]; }
    }
    const unsigned hstepA = GATHER ? 0u : (unsigned)(HALF * 2) * (unsigned)lda;
    f32x4 acc[2][2][4][2];
#pragma unroll
    for (int a = 0; a < 2; ++a)
#pragma unroll
        for (int b = 0; b < 2; ++b)
#pragma unroll
            for (int m = 0; m < 4; ++m)
#pragma unroll
                for (int n = 0; n < 2; ++n) asm volatile("" : "=v"(acc[a][b][m][n]));
    bf16x8 At[4][2], B0[2][2], B1[2][2]; v8i_t At8[4], B08[2], B18[2];
    unsigned cA = S.a_ptr(g, cur), cB = S.b_ptr(g, cur);
    if constexpr (Epi::META) E.meta_issue(cur, 0, wid, lane);
    PG8_STAGE(PG8_SB(0, 0), cB, voffB); PG8_STAGE(PG8_SB(0, 1), cB + hstepB, voffB); PG8_STAGE(PG8_SA(0, 0), cA, cvA[0]); PG8_STAGE(PG8_SA(0, 1), cA + hstepA, cvA[1]);
    if (wr == 1) PG8_BAR;
    PG8_WAIT_V(2); PG8_BAR;
    PG8_STAGE(PG8_SB(1, 0), cB + kstep, voffB); PG8_STAGE(PG8_SA(1, 0), cA + kstepA, cvA[0]); PG8_STAGE(PG8_SB(1, 1), cB + hstepB + kstep, voffB);
    PG8_WAIT_V(6); PG8_BAR;
    for (;;) {
        const bool has_next = S.next(ui + 1, nxt);
        const unsigned nA = has_next ? S.a_ptr(g, nxt) : cA, nB = has_next ? S.b_ptr(g, nxt) : cB;
#pragma nounroll
        for (int t = 0; t < nt; t += 2) {
            const bool last = (t == nt - 2);
            if constexpr (Hook::ENABLED) { if (t == (nt >> 1)) { asm volatile("s_nop 15\n\ts_nop 15" ::: "memory"); H(acc, cur, wr, wc, fr, fq); } }
            const unsigned tk = (unsigned)t * kstep, tkA = (unsigned)t * kstepA;
            const unsigned a1 = cA + tkA + kstepA;
            const unsigned a2 = last ? nA : cA + tkA + 2 * kstepA, b2 = last ? nB : cB + tk + 2 * kstep;
            const unsigned a3 = a2 + kstepA, b3 = b2 + kstep;
            if constexpr (GATHER) { if (last && has_next) {
#pragma unroll
                    for (int i = 0; i < 2; ++i) cvA[0][i] = S.row_off(ui + 1, PG8_RA(i)) + (unsigned)PG8_CA(i) * 2u; } }
            unsigned w0[2], w1[2];
#pragma unroll
            for (int i = 0; i < 2; ++i) { w0[i] = cvA[0][i]; w1[i] = cvA[1][i]; }
#if PG8_DMA_IN_MMA
            PG8_LDB(B0, 0, 0); PG8_LDB(B1, 0, 1); PG8_SCHED; PG8_LDA(At, 0, 0);
            PG8_WAIT_V(6); PG8_WAIT_L(0); PG8_BAR; PG8_MMA(0, 0, At, B0); PG8_STAGE(PG8_SA(1, 1), a1 + hstepA, cvA[1]); PG8_MMA(0, 1, At, B1); PG8_BAR; PG8_SCHED;
            if constexpr (GATHER) { if (last && has_next) {
#pragma unroll
                    for (int i = 0; i < 2; ++i) { cvA[1][i] = S.row_off(ui + 1, HALF + PG8_RA(i)) + (unsigned)PG8_CA(i) * 2u; w1[i] = cvA[1][i]; } } }
            PG8_LDA(At, 0, 1);
            PG8_WAIT_V(2); PG8_WAIT_L(0); PG8_BAR; PG8_MMA(1, 0, At, B0); PG8_STAGE(PG8_SB(0, 0), b2, voffB); PG8_STAGE(PG8_SB(0, 1), b2 + hstepB, voffB); PG8_MMA(1, 1, At, B1); PG8_STAGE(PG8_SA(0, 0), a2, w0); PG8_BAR; PG8_SCHED;
            PG8_LDB(B0, 1, 0); PG8_LDB(B1, 1, 1); PG8_SCHED; PG8_LDA(At, 1, 0);
            PG8_WAIT_V(6); PG8_WAIT_L(0); PG8_BAR; PG8_MMA(0, 0, At, B0); PG8_STAGE(PG8_SA(0, 1), a2 + hstepA, w1); PG8_MMA(0, 1, At, B1); PG8_BAR; PG8_SCHED;
            PG8_LDA(At, 1, 1);
            PG8_WAIT_V(2); PG8_WAIT_L(0); PG8_BAR; PG8_MMA(1, 0, At, B0); PG8_STAGE(PG8_SB(1, 0), b3, voffB); PG8_STAGE(PG8_SB(1, 1), b3 + hstepB, voffB); PG8_MMA(1, 1, At, B1); PG8_STAGE(PG8_SA(1, 0), a3, w0); PG8_BAR; PG8_SCHED;
#else
            PG8_LDB(B0, 0, 0); PG8_LDB(B1, 0, 1); PG8_SCHED; PG8_LDA(At, 0, 0); PG8_STAGE(PG8_SA(1, 1), a1 + hstepA, cvA[1]);
            PG8_WAIT_V(8); PG8_WAIT_L(0); PG8_BAR; if (t == 0) { PG8_MMA0(0, 0, At, B0); PG8_MMA0(0, 1, At, B1); } else { PG8_MMA(0, 0, At, B0); PG8_MMA(0, 1, At, B1); } PG8_BAR; PG8_SCHED;
            if constexpr (GATHER) { if (last && has_next) {
#pragma unroll
                    for (int i = 0; i < 2; ++i) { cvA[1][i] = S.row_off(ui + 1, HALF + PG8_RA(i)) + (unsigned)PG8_CA(i) * 2u; w1[i] = cvA[1][i]; } } }
            if constexpr (Epi::META) { if (t == 0 && has_next) E.meta_issue(nxt, (ui + 1) & 1, wid, lane); }
            PG8_LDA(At, 0, 1); PG8_STAGE(PG8_SB(0, 0), b2, voffB); PG8_STAGE(PG8_SB(0, 1), b2 + hstepB, voffB); PG8_STAGE(PG8_SA(0, 0), a2, w0);
            PG8_WAIT_V(8); PG8_WAIT_L(0); PG8_BAR; if (t == 0) { PG8_MMA0(1, 0, At, B0); PG8_MMA0(1, 1, At, B1); } else { PG8_MMA(1, 0, At, B0); PG8_MMA(1, 1, At, B1); } PG8_BAR; PG8_SCHED;
            PG8_LDB(B0, 1, 0); PG8_LDB(B1, 1, 1); PG8_SCHED; PG8_LDA(At, 1, 0); PG8_STAGE(PG8_SA(0, 1), a2 + hstepA, w1);
            PG8_WAIT_V(8); PG8_WAIT_L(0); PG8_BAR; PG8_MMA(0, 0, At, B0); PG8_MMA(0, 1, At, B1); PG8_BAR; PG8_SCHED;
            PG8_LDA(At, 1, 1); PG8_STAGE(PG8_SB(1, 0), b3, voffB); PG8_STAGE(PG8_SB(1, 1), b3 + hstepB, voffB); PG8_STAGE(PG8_SA(1, 0), a3, w0);
            PG8_WAIT_V(8); PG8_WAIT_L(0); PG8_BAR; PG8_MMA(1, 0, At, B0); PG8_MMA(1, 1, At, B1); PG8_BAR; PG8_SCHED;
#endif
        }
        if constexpr (ALIGN_EPI) { if (wr == 0) PG8_BAR; }
        asm volatile("s_nop 15\n\ts_nop 15" ::: "memory");
        if constexpr (Rider::ENABLED) {
            const int item_ = (R.slot_base + (int)S.lin(ui)) * 8 + wid; const bool ok_ = item_ < Rider::NITEMS;
            if constexpr (Epi::META) {
                f32x4 rq_[4]; const bool okq_ = item_ < 2 * Rider::NITEMS;
                if (okq_) R.load4(rq_, item_ >> 1, item_ & 1, lane);
                E.run(acc, cur, wr, wc, fr, fq, ui & 1);
                if (okq_) R.store4(rq_, item_ >> 1, item_ & 1, lane);
            } else { f32x4 rv_[8];
                if (ok_) R.load(rv_, item_, lane);
                E(acc, cur, wr, wc, fr, fq);
                if (ok_) R.store(rv_, item_, lane); }
        } else if constexpr (Epi::META) E.run(acc, cur, wr, wc, fr, fq, ui & 1);
        else E(acc, cur, wr, wc, fr, fq);
        if (!has_next) break;
#pragma unroll
        for (int a = 0; a < 2; ++a)
#pragma unroll
            for (int b = 0; b < 2; ++b)
#pragma unroll
                for (int m = 0; m < 4; ++m)
#pragma unroll
                    for (int n = 0; n < 2; ++n) asm volatile("" : "=v"(acc[a][b][m][n]));
        cur = nxt; cA = nA; cB = nB; ++ui;
        if constexpr (ALIGN_EPI) { if (wr == 1) PG8_BAR; }
    }
    PG8_WAIT_V(0);
    if constexpr (!ALIGN_EPI) { if (wr == 0) PG8_BAR; }
    PG8_BAR;
#undef PG8_RA
#undef PG8_CA
#undef PG8_SA
#undef PG8_SB
#undef PG8_STAGE
#undef PG8_LDA
#undef PG8_LDB
#undef PG8_MMA
#undef PG8_MMA0
#undef PG8_WAIT_V
#undef PG8_WAIT_L
#undef PG8_BAR
#undef PG8_SCHED
}
}
namespace att {
#define ALAS __attribute__((address_space(3)))
typedef short bf16x8 __attribute__((ext_vector_type(8)));
typedef short s16x4 __attribute__((ext_vector_type(4)));
typedef short v4i16_t __attribute__((ext_vector_type(4)));
typedef float f32x16 __attribute__((ext_vector_type(16)));
typedef unsigned u32x4 __attribute__((ext_vector_type(4)));
typedef unsigned u32x2 __attribute__((ext_vector_type(2)));
typedef unsigned short bf16_t;
constexpr int SEQ = 4096, PW = 4352;
constexpr int QA = 0, KA = 512, VA = 640, QB = 768, KB = 1280, VB = 1792;
constexpr float LOG2E = 1.4426950408889634f;
constexpr float SB_EXIT = -40.0f;

__device__ __forceinline__ int crow(int r, int hi) { return (r & 3) + 8 * (r >> 2) + 4 * hi; }
__device__ __forceinline__ unsigned cvtpk(float lo, float hi) { typedef float f2 __attribute__((ext_vector_type(2))); typedef __bf16 b2 __attribute__((ext_vector_type(2))); f2 v = {lo, hi}; b2 b = __builtin_convertvector(v, b2); return __builtin_bit_cast(unsigned, b); }
__device__ __forceinline__ float bflo(unsigned u) { return __uint_as_float(u << 16); }
__device__ __forceinline__ float bfhi(unsigned u) { return __uint_as_float(u & 0xffff0000u); }
__device__ __forceinline__ s16x4 vtr(const ALAS char* p) { return __builtin_bit_cast(s16x4, __builtin_amdgcn_ds_read_tr16_b64_v4i16((ALAS v4i16_t*)p)); }
#define AT_FENCE() asm volatile("" ::: "memory")

__device__ __forceinline__ void pack_tile(const f32x16& x, bf16x8& f0, bf16x8& f1) {
    u32x4 a, b;
    a.x = cvtpk(x[0], x[1]); a.y = cvtpk(x[2], x[3]); a.z = cvtpk(x[4], x[5]); a.w = cvtpk(x[6], x[7]);
    b.x = cvtpk(x[8], x[9]); b.y = cvtpk(x[10], x[11]); b.z = cvtpk(x[12], x[13]); b.w = cvtpk(x[14], x[15]);
    f0 = __builtin_bit_cast(bf16x8, a); f1 = __builtin_bit_cast(bf16x8, b);
}
__device__ __forceinline__ void v_load(u32x4 (&vr)[4], const bf16_t* Vp, int lane) {
    const unsigned lo = (unsigned)((lane >> 3) * PW + 8 * (lane & 7)) * 2u;
#pragma unroll
    for (int i = 0; i < 4; ++i) vr[i] = *(const u32x4*)((const char*)Vp + (lo + (unsigned)(8 * i * PW * 2)));
}
__device__ __forceinline__ void v_store(const u32x4 (&vr)[4], ALAS char* vl, int lane) {
#pragma unroll
    for (int i = 0; i < 4; ++i) *(ALAS u32x4*)(vl + (8 * i + (lane >> 3)) * 128 + 16 * (lane & 7)) = vr[i];
}
__device__ __forceinline__ void k_load(u32x4 (&kr)[4], const bf16_t* Kp, int lane) {
    const unsigned lo = (unsigned)((lane >> 3) * PW + 8 * (lane & 7)) * 2u;
#pragma unroll
    for (int i = 0; i < 4; ++i) kr[i] = *(const u32x4*)((const char*)Kp + (lo + (unsigned)(8 * i * PW * 2)));
}
__device__ __forceinline__ void k_store(const u32x4 (&kr)[4], ALAS char* kl, int lane) {
#pragma unroll
    for (int i = 0; i < 4; ++i) { const int row = 8 * i + (lane >> 3); *(ALAS u32x4*)(kl + row * 128 + 16 * ((lane & 7) ^ (row & 7))) = kr[i]; }
}
__device__ __forceinline__ void k_frags(u32x4 (&f)[4], const ALAS char* kl, int r32, int hi) {
#pragma unroll
    for (int ks = 0; ks < 4; ++ks) f[ks] = *(const ALAS u32x4*)(kl + r32 * 128 + 16 * ((2 * ks + hi) ^ (r32 & 7)));
}
__device__ __forceinline__ void pv(f32x16& o0, f32x16& o1, const ALAS char* vl, int lane, const bf16x8& p0, const bf16x8& p1) {
    const int g = lane >> 4, i = lane & 15, hi = lane >> 5;
    const ALAS char* base = vl + (4 * hi + (i >> 2)) * 128 + (16 * (g & 1) + 4 * (i & 3)) * 2;
#pragma unroll
    for (int db = 0; db < 2; ++db) {
#pragma unroll
        for (int ks = 0; ks < 2; ++ks) {
            const s16x4 lo = vtr(base + ks * 2048 + db * 64), hh = vtr(base + ks * 2048 + db * 64 + 1024);
            const bf16x8 a = (bf16x8){lo[0], lo[1], lo[2], lo[3], hh[0], hh[1], hh[2], hh[3]};
            if (db == 0) o0 = __builtin_amdgcn_mfma_f32_32x32x16_bf16(a, ks ? p1 : p0, o0, 0, 0, 0);
            else         o1 = __builtin_amdgcn_mfma_f32_32x32x16_bf16(a, ks ? p1 : p0, o1, 0, 0, 0);
        }
    }
}
__device__ __forceinline__ void o_store(const f32x16& o0, const f32x16& o1, float s, bf16_t* Op, int ldo, int r32, int hi, ALAS char* tl, int lane) {
    ALAS char* rowp = tl + r32 * 128 + 8 * hi;
#pragma unroll
    for (int gq = 0; gq < 4; ++gq) {
        u32x2 w0, w1;
        w0.x = cvtpk(o0[4 * gq] * s, o0[4 * gq + 1] * s); w0.y = cvtpk(o0[4 * gq + 2] * s, o0[4 * gq + 3] * s);
        w1.x = cvtpk(o1[4 * gq] * s, o1[4 * gq + 1] * s); w1.y = cvtpk(o1[4 * gq + 2] * s, o1[4 * gq + 3] * s);
        *(ALAS u32x2*)(rowp + 16 * gq) = w0; *(ALAS u32x2*)(rowp + 64 + 16 * gq) = w1;
    }
    AT_FENCE();
#pragma unroll
    for (int i = 0; i < 4; ++i) { const int row = 8 * i + (lane >> 3); const u32x4 v = *(const ALAS u32x4*)(tl + row * 128 + 16 * (lane & 7)); *(u32x4*)(Op + (size_t)row * ldo + 8 * (lane & 7)) = v; }
    AT_FENCE();
}

typedef float f32x4 __attribute__((ext_vector_type(4)));
__device__ __forceinline__ void gu_item_load(f32x4 (&v)[16], const float* wgu, int item, int lane) {
    const int e = item >> 9, q = item & 511, kb = q >> 6, nb = q & 63, g = lane >> 3, c = lane & 7;
    const float* W = wgu + (size_t)e * 1024 * 2048 + (size_t)(128 * kb + 16 * g) * 2048 + 32 * nb + 4 * c;
#pragma unroll
    for (int i = 0; i < 16; ++i) v[i] = __builtin_nontemporal_load((const f32x4*)(W + (size_t)i * 2048));
}
__device__ __forceinline__ unsigned pk4_e4m3(float a, float b, float c, float d) {
    int r = __builtin_amdgcn_cvt_pk_fp8_f32(__builtin_amdgcn_fmed3f(a, -448.f, 448.f), __builtin_amdgcn_fmed3f(b, -448.f, 448.f), 0, false);
    r = __builtin_amdgcn_cvt_pk_fp8_f32(__builtin_amdgcn_fmed3f(c, -448.f, 448.f), __builtin_amdgcn_fmed3f(d, -448.f, 448.f), r, true); return (unsigned)r; }
__device__ __forceinline__ void gu_item_store(const f32x4 (&v)[16], unsigned char* WGU8, int item, int lane) {
    const int e = item >> 9, q = item & 511, kb = q >> 6, nb = q & 63, g = lane >> 3, c = lane & 7, n0 = 32 * nb;
    const int c0 = n0 & 1023, drow0 = 256 * (c0 >> 7) + (n0 >= 1024 ? 128 : 0) + (c0 & 127);
    unsigned char* dst = WGU8 + (size_t)e * 2048 * 1024 + (size_t)(drow0 + 4 * c) * 1024 + 128 * kb + 16 * g;
#pragma unroll
    for (int j = 0; j < 4; ++j) { u32x4 o;
#pragma unroll
        for (int qq = 0; qq < 4; ++qq) o[qq] = pk4_e4m3(v[4 * qq][j] * 32.0f, v[4 * qq + 1][j] * 32.0f, v[4 * qq + 2][j] * 32.0f, v[4 * qq + 3][j] * 32.0f);
        __builtin_nontemporal_store(o, (u32x4*)(dst + (size_t)j * 1024)); }
}
constexpr int GU_ITEMS = 32 * 8 * 64;
#ifndef NCONV
#define NCONV 1
#endif
constexpr int GU_FIRST_ITEM = 17408 / 2;

__device__ __forceinline__ void kv_dma(__amdgpu_buffer_rsrc_t rs, unsigned koff, unsigned voff, ALAS char* buf, int lane) {
    const int r = lane >> 3, c = lane & 7;
    const unsigned ko = (unsigned)(r * PW + 8 * (c ^ r)) * 2u, vo = (unsigned)(r * PW + 8 * c) * 2u;
#pragma unroll
    for (int i = 0; i < 4; ++i) {
        __builtin_amdgcn_raw_ptr_buffer_load_lds(rs, (ALAS unsigned*)(buf + i * 1024), 16, (int)ko, (int)(koff + (unsigned)(8 * i * PW * 2)), 0, 0);
        __builtin_amdgcn_raw_ptr_buffer_load_lds(rs, (ALAS unsigned*)(buf + 4096 + i * 1024), 16, (int)vo, (int)(voff + (unsigned)(8 * i * PW * 2)), 0, 0);
    }
}
__device__ __forceinline__ int lane_id() { int l; asm volatile("v_mbcnt_lo_u32_b32 %0, -1, 0\n\tv_mbcnt_hi_u32_b32 %0, -1, %0" : "=v"(l)); return l; }
#define AT_WAIT_V(n) asm volatile("s_waitcnt vmcnt(" #n ")" ::: "memory")
#define AT_WAIT_L0() asm volatile("s_waitcnt lgkmcnt(0)" ::: "memory")

__device__ __forceinline__ void sb_unit(const bf16_t* P, __amdgpu_buffer_rsrc_t rs, unsigned pbase, bf16_t* YB, int b, int head, int qblk, ALAS char* wl, int lane) {
    const int r32 = lane & 31, hi = lane >> 5;
    const size_t row0 = (size_t)b * SEQ + 32 * qblk;
    const bf16_t* Qp = P + row0 * PW + QB + 64 * head;
    bf16x8 qf[4];
#pragma unroll
    for (int ks = 0; ks < 4; ++ks) qf[ks] = *(const bf16x8*)(Qp + (size_t)r32 * PW + 16 * ks + 8 * hi);
    bf16x8 U0, U1;
#pragma unroll
    for (int j = 0; j < 8; ++j) { const int k0 = 8 * (j >> 2) + 4 * hi + (j & 3); U0[j] = (k0 > r32) ? (short)0x3F80 : (short)0; U1[j] = (16 + k0 > r32) ? (short)0x3F80 : (short)0; }
    float C = 0.f;
    f32x16 o0 = {}, o1 = {};
    AT_WAIT_L0(); kv_dma(rs, pbase + (unsigned)(row0 * PW + KB + 64 * head) * 2u, pbase + (unsigned)(row0 * PW + VB + 64 * head) * 2u, wl, lane);
    for (int j = 0; j <= qblk; ++j) {
        const size_t krow0 = (size_t)b * SEQ + 32 * (qblk - j);
        ALAS char* kl = wl + (j & 1) * 8192; ALAS char* vl = kl + 4096;
        if (j < qblk) { AT_WAIT_L0(); kv_dma(rs, pbase + (unsigned)((krow0 - 32) * PW + KB + 64 * head) * 2u, pbase + (unsigned)((krow0 - 32) * PW + VB + 64 * head) * 2u, wl + ((j + 1) & 1) * 8192, lane); AT_WAIT_V(8); }
        else AT_WAIT_V(0);
        u32x4 kf[4]; k_frags(kf, kl, r32, hi);
        f32x16 z = {};
#pragma unroll
        for (int ks = 0; ks < 4; ++ks) z = __builtin_amdgcn_mfma_f32_32x32x16_bf16(__builtin_bit_cast(bf16x8, kf[ks]), qf[ks], z, 0, 0, 0);
        f32x16 lk, ls;
        int rq = r32; asm volatile("" : "+v"(rq));
#pragma unroll
        for (int r = 0; r < 16; ++r) {
            const float z2 = z[r];
            const float t = __builtin_amdgcn_exp2f(-fabsf(z2));
            const float l = __builtin_amdgcn_logf(1.0f + t);
            float lkv = -(fmaxf(z2, 0.f) + l);
            float lsv = fminf(z2, 0.f) - l;
            if (j == 0 && !(crow(r, hi) < rq)) { lkv = 0.f; lsv = -INFINITY; }
            lk[r] = lkv; ls[r] = lsv;
        }
        bf16x8 x0, x1; pack_tile(lk, x0, x1);
        f32x16 Y;
#pragma unroll
        for (int r = 0; r < 16; ++r) Y[r] = C;
        Y = __builtin_amdgcn_mfma_f32_32x32x16_bf16(U0, x0, Y, 0, 0, 0);
        Y = __builtin_amdgcn_mfma_f32_32x32x16_bf16(U1, x1, Y, 0, 0, 0);
        const float cn = Y[0] + lk[0];
        C = __shfl(cn, r32);
        f32x16 w;
#pragma unroll
        for (int r = 0; r < 16; ++r) w[r] = __builtin_amdgcn_exp2f(ls[r] + Y[r]);
        bf16x8 p0, p1; pack_tile(w, p0, p1);
        AT_FENCE(); pv(o0, o1, vl, lane, p0, p1); AT_FENCE();
        if (__all(C < SB_EXIT)) break;
    }
    AT_WAIT_V(0); AT_WAIT_L0();
    o_store(o0, o1, 1.0f, YB + row0 * 1024 + 512 + 64 * head, 1024, r32, hi, wl, lane);
}

__device__ __forceinline__ void swa_unit(const bf16_t* P, __amdgpu_buffer_rsrc_t rs, unsigned pbase, bf16_t* YA, const ALAS float* wqk, const float* sinks, int b, int head, int qblk, ALAS char* wl, int lane) {
    const int r32 = lane & 31, hi = lane >> 5, kvh = head >> 2;
    const size_t row0 = (size_t)b * SEQ + 32 * qblk;
    const float slope2 = exp2f(-(float)(head + 1)) * LOG2E;
    AT_WAIT_L0(); kv_dma(rs, pbase + (unsigned)(row0 * PW + KA + 64 * kvh) * 2u, pbase + (unsigned)(row0 * PW + VA + 64 * kvh) * 2u, wl, lane);
    bf16x8 qf[4];
    {
        const bf16_t* Qp = P + row0 * PW + QA + 64 * head + (size_t)r32 * PW + 8 * hi;
        u32x4 raw[4]; float ss = 0.f;
#pragma unroll
        for (int ks = 0; ks < 4; ++ks) { raw[ks] = *(const u32x4*)(Qp + 16 * ks);
#pragma unroll
            for (int d = 0; d < 4; ++d) { const float a = bflo(raw[ks][d]), c = bfhi(raw[ks][d]); ss += a * a + c * c; } }
        ss += __shfl_xor(ss, 32);
        const float rq = rsqrtf(ss * (1.0f / 64.0f) + 1e-5f) * (0.125f * LOG2E);
#pragma unroll
        for (int ks = 0; ks < 4; ++ks) { u32x4 o;
#pragma unroll
            for (int d = 0; d < 4; ++d) { const int dd = 16 * ks + 8 * hi + 2 * d;
                o[d] = cvtpk(bflo(raw[ks][d]) * rq * wqk[dd], bfhi(raw[ks][d]) * rq * wqk[dd + 1]); }
            qf[ks] = __builtin_bit_cast(bf16x8, o); }
    }
    float m2 = sinks[head] * LOG2E;
    float l = (hi == 0) ? 1.0f : 0.f;
    f32x16 o0 = {}, o1 = {};
    for (int j = 0; j < 5; ++j) {
        const int kb = qblk - j; if (kb < 0) break;
        const size_t krow0 = (size_t)b * SEQ + 32 * kb;
        ALAS char* kl = wl + (j & 1) * 8192; ALAS char* vl = kl + 4096;
        if (j < 4 && kb > 0) { AT_WAIT_L0(); kv_dma(rs, pbase + (unsigned)((krow0 - 32) * PW + KA + 64 * kvh) * 2u, pbase + (unsigned)((krow0 - 32) * PW + VA + 64 * kvh) * 2u, wl + ((j + 1) & 1) * 8192, lane); AT_WAIT_V(8); }
        else AT_WAIT_V(0);
        u32x4 raw[4]; k_frags(raw, kl, r32, hi);
        bf16x8 kf[4];
        {
            float ss = 0.f;
#pragma unroll
            for (int ks = 0; ks < 4; ++ks) {
#pragma unroll
                for (int d = 0; d < 4; ++d) { const float a = bflo(raw[ks][d]), c = bfhi(raw[ks][d]); ss += a * a + c * c; } }
            ss += __shfl_xor(ss, 32);
            const float rk = rsqrtf(ss * (1.0f / 64.0f) + 1e-5f);
#pragma unroll
            for (int ks = 0; ks < 4; ++ks) { u32x4 o;
#pragma unroll
                for (int d = 0; d < 4; ++d) o[d] = cvtpk(bflo(raw[ks][d]) * rk, bfhi(raw[ks][d]) * rk);
                kf[ks] = __builtin_bit_cast(bf16x8, o); }
        }
        f32x16 z = {};
#pragma unroll
        for (int ks = 0; ks < 4; ++ks) z = __builtin_amdgcn_mfma_f32_32x32x16_bf16(kf[ks], qf[ks], z, 0, 0, 0);
        float tmax = -INFINITY;
        int rq = r32; asm volatile("" : "+v"(rq));
#pragma unroll
        for (int r = 0; r < 16; ++r) {
            const int c = crow(r, hi);
            float s2 = z[r] - slope2 * (float)(32 * j + rq - c);
            if (j == 0 && c > rq) s2 = -INFINITY;
            if (j == 4 && !(c > rq)) s2 = -INFINITY;
            z[r] = s2; tmax = fmaxf(tmax, s2);
        }
        tmax = fmaxf(tmax, __shfl_xor(tmax, 32));
        const float mn = fmaxf(m2, tmax);
        const float alpha = __builtin_amdgcn_exp2f(m2 - mn);
        m2 = mn; l *= alpha;
#pragma unroll
        for (int r = 0; r < 16; ++r) { o0[r] *= alpha; o1[r] *= alpha; }
        float ps = 0.f;
#pragma unroll
        for (int r = 0; r < 16; ++r) { const float p = __builtin_amdgcn_exp2f(z[r] - mn); z[r] = p; ps += p; }
        l += ps;
        bf16x8 p0, p1; pack_tile(z, p0, p1);
        AT_FENCE(); pv(o0, o1, vl, lane, p0, p1); AT_FENCE();
    }
    l += __shfl_xor(l, 32);
    AT_WAIT_L0();
    o_store(o0, o1, 1.0f / l, YA + row0 * 1024 + 64 * head, 1024, r32, hi, wl, lane);
}

__device__ __forceinline__ void attn_phase(ALAS char* lds, const bf16_t* P, bf16_t* YA, bf16_t* YB, const float* qnw, const float* knw, const float* sinks, const float* wgu, unsigned char* WGU8, const void* wsbase, unsigned pbase, int vcu, int G, int wave, int lane, ALAS unsigned* ucnt) {
    const __amdgpu_buffer_rsrc_t rs = __builtin_amdgcn_make_buffer_rsrc((void*)wsbase, 0, 0x7fffffff, 0x00020000);
    ALAS char* wl = lds + wave * 16384;
    const int ngrp = 2048;
    ALAS float* wqk = (ALAS float*)(lds + 131072);
    if (wave == 0) wqk[lane] = qnw[lane] * knw[lane];
    __syncthreads();
    if (wave >= 8 - NCONV) {
        const int per = (GU_ITEMS - GU_FIRST_ITEM + G - 1) / G, half = (per + NCONV - 1) / NCONV, i0 = GU_FIRST_ITEM + vcu * per + (wave - (8 - NCONV)) * half;
        int i1 = i0 + half; if (i1 > GU_FIRST_ITEM + (vcu + 1) * per) i1 = GU_FIRST_ITEM + (vcu + 1) * per; if (i1 > GU_ITEMS) i1 = GU_ITEMS;
        f32x4 wa[16], wb[16];
        if (i0 < i1) gu_item_load(wa, wgu, i0, lane);
        for (int i = i0; i < i1; i += 2) {
            if (i + 1 < i1) gu_item_load(wb, wgu, i + 1, lane);
            gu_item_store(wa, WGU8, i, lane);
            if (i + 2 < i1) gu_item_load(wa, wgu, i + 2, lane);
            if (i + 1 < i1) gu_item_store(wb, WGU8, i + 1, lane);
        }
    }
    const int nunits = ((ngrp - vcu + G - 1) / G) * 8;
    for (;;) {
        unsigned tk = 0; if (lane_id() == 0) tk = __hip_atomic_fetch_add(ucnt, 1u, __ATOMIC_RELAXED, __HIP_MEMORY_SCOPE_WORKGROUP);
        const int idx = __builtin_amdgcn_readfirstlane((int)tk); if (idx >= nunits) break;
        const int it = idx >> 3, g0 = vcu + it * G;
        const int gi = (G == 256) ? (g0 & ~255) + ((vcu + 17 * it) & 255) : g0;
        const int U = gi * 8 + (idx & 7);
        const int qblk = U & 127, head = (U >> 7) & 7, b = (U >> 10) & 7, kind = U >> 13;
        int ln = lane; asm volatile("" : "+v"(ln));
        if (kind == 0) swa_unit(P, rs, pbase, YA, wqk, sinks, b, head, qblk, wl, ln);
        else sb_unit(P, rs, pbase, YB, b, head, qblk, wl, ln);
    }
}
}
constexpr int NWAVES = 8;
constexpr int N_LAUNCHES = MK_N_LAUNCHES;
constexpr int PER_PHASE = 9;

constexpr int BATCH = 8, SEQ = 4096, D = 1024, M = BATCH * SEQ, INW = 4352, NE = 32, TOPK = 4, DFF = 1024;
constexpr int GA_COL = 2304, GB_COL = 3328;
constexpr int ECAP = 32768;
constexpr int MAXTILES = 544;
constexpr float NORM_EPS = 1e-5f;
constexpr float QB_SCALE = 0.125f * 1.4426950408889634f;

constexpr size_t MiB = 1u << 20;
constexpr size_t WS_CTL = 0, CTL_ZERO_BYTES = 128 * 1024;
constexpr size_t WS_WIN = 2 * MiB;
constexpr size_t WS_PA = 11 * MiB, WS_WO = 13 * MiB;
constexpr size_t WS_LAID = 16 * MiB, WS_LRS = 20 * MiB, WS_LGATE = 24 * MiB;
constexpr size_t WS_RTAB = 28 * MiB;
constexpr size_t WS_WIN8 = 29 * MiB;
constexpr size_t WS_TG = 31 * MiB;
constexpr size_t WS_WGU = 32 * MiB;
constexpr size_t WS_WD = 160 * MiB;
constexpr size_t WS_XN = 224 * MiB;
constexpr size_t WS_YA = 288 * MiB;
constexpr size_t WS_MG = 352 * MiB;
constexpr size_t WS_PROJ = 416 * MiB;
constexpr size_t WS_YBUF = 688 * MiB;
constexpr size_t WS_XN8 = 944 * MiB;
constexpr size_t WS_END = 976 * MiB;
constexpr int CW_TMO = 0, CW_CODE = 1, CW_CNT = 64  , CW_BAR = 4096, CW_SEAM1 = 8192, CW_SEAM2 = 12288;

constexpr int RING_OFF = 0, RING_BYTES = 131072;
constexpr int LDS_BYTES = 163840;
constexpr int XTRA_OFF = RING_BYTES;
constexpr int TILETAB_OFF = XTRA_OFF;
constexpr int CNT_OFF = TILETAB_OFF + 2304;
constexpr int ROWTAB_OFF = CNT_OFF + 512;
constexpr int EPIMETA_OFF = ROWTAB_OFF + 18 * 1024 + 256;
constexpr int LDSCTL_OFF = LDS_BYTES - 1024, MISC_OFF = LDSCTL_OFF + 320;
constexpr int LATE_OFF = EPIMETA_OFF + 2 * 3072;
constexpr int ULIST_OFF = LATE_OFF + 576;
constexpr int UCACHE_OFF = ULIST_OFF + 128;
static_assert(UCACHE_OFF + 128 <= LDSCTL_OFF, "LDS map");
static_assert(EPIMETA_OFF == (int)pg8::EPIMETA && EPIMETA_OFF + 2 * (int)pg8::EPIMETA_IMG <= LDSCTL_OFF, "LDS map");
static_assert(8 * 16640 <= LDSCTL_OFF, "P0 scratch");

#define GAS __attribute__((address_space(1)))
#define LAS __attribute__((address_space(3)))
typedef unsigned short bf16;
typedef unsigned v4u __attribute__((ext_vector_type(4)));
typedef float f32x4 __attribute__((ext_vector_type(4)));
typedef float f32x16 __attribute__((ext_vector_type(16)));
typedef short bf16x8 __attribute__((ext_vector_type(8)));
typedef GAS unsigned gu32;
#define RLX_AGENT __ATOMIC_RELAXED, __HIP_MEMORY_SCOPE_AGENT
#define LDS_WAIT() asm volatile("s_waitcnt lgkmcnt(0)" ::: "memory")
#define VM_WAIT() asm volatile("s_waitcnt vmcnt(0)" ::: "memory")
__device__ __forceinline__ unsigned pk2(float lo, float hi) { return pg8::cvt_pk_bf16(lo, hi); }

#define XB_TMO      128
#define XB_XCNT(j)  (256  + 64 * (j))
#define XB_XSUB(j)  (1280 + 64 * (j))
#define XB_XGEN(j)  (2304 + 64 * (j))
#define XB_TOP      3328
#define XB_TOPGEN   3392
#define XCD_BAR_WORDS 3456
#define XB_SPIN_CAP (1u << 22)
__device__ __forceinline__ unsigned xb_ld(unsigned* p)              { return __hip_atomic_load(p, __ATOMIC_RELAXED, __HIP_MEMORY_SCOPE_AGENT); }
__device__ __forceinline__ unsigned xb_add(unsigned* p, unsigned v) { return __hip_atomic_fetch_add(p, v, __ATOMIC_RELAXED, __HIP_MEMORY_SCOPE_AGENT); }
__device__ __forceinline__ unsigned xb_xcc_id() { return (unsigned)__builtin_amdgcn_s_getreg((3 << 11) | 20) & 0xFu; }
#define XB_SPIN(cond, bar) do { unsigned _sp = 0; while (cond) { __builtin_amdgcn_s_sleep(1); \
    if ((++_sp & 255u) == 0u) { if (xb_ld(&(bar)[XB_TMO])) break; if (_sp > XB_SPIN_CAP) { atomicAdd(&(bar)[XB_TMO], 1u); break; } } } } while (0)
struct XcdBarrier { unsigned* bar; unsigned x; volatile LAS unsigned* st; };
__device__ __forceinline__ XcdBarrier xcd_barrier_post(unsigned* bar, volatile LAS unsigned* st, bool tid0) {
    XcdBarrier b; b.bar = bar; b.x = xb_xcc_id(); b.st = st;
    if (tid0) (void)xb_add(&bar[XB_XCNT(b.x)], 1u);
    return b;
}
__device__ __forceinline__ void xcd_barrier_complete(unsigned* bar, unsigned x, unsigned& nloc, unsigned& nx) {
    const unsigned G = gridDim.x * gridDim.y * gridDim.z;
    unsigned sum, cnt, mine, sp = 0u;
    for (;;) {
        sum = 0u; cnt = 0u; mine = 0u;
#pragma unroll
        for (unsigned j = 0; j < 16; ++j) { const unsigned c = xb_ld(&bar[XB_XCNT(j)]); sum += c; cnt += (c > 0u) ? 1u : 0u; mine = (j == x) ? c : mine; }
        if (sum == G) break;
        __builtin_amdgcn_s_sleep(1);
        if ((++sp & 255u) == 0u) { if (xb_ld(&bar[XB_TMO])) break; if (sp > XB_SPIN_CAP) { atomicAdd(&bar[XB_TMO], 1u); break; } }
    }
    nloc = mine > 0u ? mine : 1u; nx = cnt > 0u ? cnt : 1u;
}
__device__ __forceinline__ void xcd_barrier(const XcdBarrier& b, bool tid0) {
    asm volatile("s_waitcnt vmcnt(0)" ::: "memory");
    __syncthreads();
    if (tid0) {
        unsigned* bar = b.bar;
        __builtin_amdgcn_s_waitcnt(0);
        unsigned nloc = b.st[0], nx = b.st[1];
        if (nloc == 0u) { xcd_barrier_complete(bar, b.x, nloc, nx); b.st[0] = nloc; b.st[1] = nx; }
        const unsigned old = xb_add(&bar[XB_XSUB(b.x)], 1u);
        const unsigned gen = old / nloc;
        if (old + 1u == (gen + 1u) * nloc) {
            __builtin_amdgcn_fence(__ATOMIC_RELEASE, "agent");
            asm volatile("s_waitcnt vmcnt(0)" ::: "memory");
            const unsigned og = xb_add(&bar[XB_TOP], 1u);
            const unsigned tg = og / nx;
            if (og + 1u == (tg + 1u) * nx) xb_add(&bar[XB_TOPGEN], 1u);
            else XB_SPIN(xb_ld(&bar[XB_TOPGEN]) == tg, bar);
            __builtin_amdgcn_fence(__ATOMIC_ACQUIRE, "agent");
            asm volatile("s_waitcnt vmcnt(0)" ::: "memory");
        } else {
            XB_SPIN(xb_ld(&bar[XB_TOPGEN]) == gen, bar);
            __builtin_amdgcn_fence(__ATOMIC_ACQUIRE, "agent");
            asm volatile("s_waitcnt vmcnt(0)" ::: "memory");
        }
    }
    __syncthreads();
}

#define SB_XCNT(j) (64 * (j))
#define SB_TOP     1024
__device__ __forceinline__ void seam_arrive(unsigned* sb, unsigned x, unsigned nloc, bool tid0) {
    if (tid0) { const unsigned old = xb_add(&sb[SB_XCNT(x)], 1u);
        if (old + 1u == nloc) { __builtin_amdgcn_fence(__ATOMIC_RELEASE, "agent"); asm volatile("s_waitcnt vmcnt(0)" ::: "memory"); (void)xb_add(&sb[SB_TOP], 1u); } }
}
__device__ __forceinline__ void seam_wait(unsigned* sb, unsigned nx, unsigned* mainbar, bool tid0) {
    if (tid0) { XB_SPIN(xb_ld(&sb[SB_TOP]) != nx, mainbar); __builtin_amdgcn_fence(__ATOMIC_ACQUIRE, "agent"); asm volatile("s_waitcnt vmcnt(0)" ::: "memory"); }
    __syncthreads();
}

struct Frame {
    LAS unsigned char* lds;
    volatile LAS unsigned* MISC;
    gu32* ctl;
    int wave;
    int vcu, G;
    float* out;
    unsigned char* ws;
};

__device__ __forceinline__ float wave_sum(float v) {
#pragma unroll
    for (int o = 1; o < 64; o <<= 1) v += __shfl_xor(v, o);
    return v;
}

template <bool FP8, bool DPERM = false, bool WPERM = false>
__device__ __forceinline__ void p0_item(const float* W, int N, void* WT, int Kdst, int ksrc, int kdst, int n0, int drow0, float scale, int lane) {
    const int g = lane >> 3, c = lane & 7;
    f32x4 v[16];
#pragma unroll
    for (int i = 0; i < 16; ++i) v[i] = __builtin_nontemporal_load((const f32x4*)(W + (size_t)(ksrc + 16 * g + i) * N + n0 + 4 * c));
#pragma unroll
    for (int j = 0; j < 4; ++j) {
        if constexpr (FP8) { v4u o;
#pragma unroll
            for (int q = 0; q < 4; ++q) o[q] = pg8::pk4_fp8(v[4 * q][j] * scale, v[4 * q + 1][j] * scale, v[4 * q + 2][j] * scale, v[4 * q + 3][j] * scale);
            int drow = drow0 + 4 * c + j;
            if constexpr (DPERM) { const int n = drow & 255; drow = (drow & ~255) + 128 * ((n >> 3) & 1) + 32 * (n >> 6) + 8 * ((n >> 4) & 3) + (n & 7); }
            if constexpr (WPERM) { const int n = drow & 255; drow = (drow & ~255) + 128 * ((n >> 5) & 1) + 32 * (n >> 6) + (n & 31); }
            if constexpr (DPERM) __builtin_nontemporal_store(o, (v4u*)((unsigned char*)WT + (size_t)drow * Kdst + kdst + 16 * g)); else *(v4u*)((unsigned char*)WT + (size_t)drow * Kdst + kdst + 16 * g) = o;
        } else { v4u o0, o1;
#pragma unroll
            for (int q = 0; q < 4; ++q) { o0[q] = pk2(v[2 * q][j] * scale, v[2 * q + 1][j] * scale); o1[q] = pk2(v[8 + 2 * q][j] * scale, v[9 + 2 * q][j] * scale); }
            int drow = drow0 + 4 * c + j;
            if constexpr (WPERM) { const int n = drow & 255; drow = (drow & ~255) + 128 * ((n >> 5) & 1) + 32 * (n >> 6) + (n & 31); }
            bf16* dp = (bf16*)WT + (size_t)drow * Kdst + kdst + 16 * g; *(v4u*)dp = o0; *(v4u*)(dp + 8) = o1; }
    }
}
__device__ __forceinline__ void p0_prologue(Frame& F, const float* x, const float* anw, const float* win, const float* wpa, const float* wpb, const float* wo, const float* wgu, const float* wd, const float* fnw, const float* rw) {
    (void)wgu; (void)wd;
    const int lane = pg8::lane_now();
    const int gw = F.vcu * NWAVES + F.wave, NGW = F.G * NWAVES;
    bf16* WIN = (bf16*)(F.ws + WS_WIN); bf16* PA = (bf16*)(F.ws + WS_PA); bf16* WO = (bf16*)(F.ws + WS_WO);
    bf16* XN = (bf16*)(F.ws + WS_XN);
    constexpr int I_IN = 8 * 136, I_PA = 4 * 32, I_WO = 8 * 32;
    constexpr int NITEMS = I_IN + 2 * I_PA + I_WO;
    for (int it = gw; it < NITEMS; it += NGW) {
        int r = it;
        if (r < I_IN) { const int kb = r / 136, nb = r % 136, n0 = 32 * nb; const float sc = (n0 >= 768 && n0 < 1280) ? QB_SCALE : 1.0f;
            if (n0 < GA_COL) p0_item<false, false, true>(win, INW, WIN, 1024, 128 * kb, 128 * kb, n0, n0, sc, lane);
            else p0_item<true, false, true>(win, INW, F.ws + WS_WIN8, 1024, 128 * kb, 128 * kb, n0, n0 - GA_COL, 32.0f, lane);
            continue; } r -= I_IN;
        if (r < I_PA) { const int kb = r / 32, nb = r % 32; p0_item<false>(wpa, 1024, PA, 1024, 128 * kb, 128 * kb, 32 * nb, 32 * nb, 1.0f, lane); continue; } r -= I_PA;
        if (r < I_PA) { const int kb = r / 32, nb = r % 32; p0_item<false>(wpb, 1024, PA, 1024, 128 * kb, 512 + 128 * kb, 32 * nb, 32 * nb, 1.0f, lane); continue; } r -= I_PA;
        { const int kb = r / 32, nb = r % 32; p0_item<false>(wo, 1024, WO, 1024, 128 * kb, 128 * kb, 32 * nb, 32 * nb, 1.0f, lane); }
    }
    for (int ks = gw; ks < 64; ks += NGW) { const int l = lane, e = l & 31, hh = l >> 5;
        float v[8];
#pragma unroll
        for (int j = 0; j < 8; ++j) { const int k = 16 * ks + 8 * hh + j; v[j] = fnw[k] * rw[k * NE + e]; }
        v4u oh, ol;
#pragma unroll
        for (int j = 0; j < 4; ++j) { const unsigned ph = pk2(v[2 * j], v[2 * j + 1]); oh[j] = ph; ol[j] = pk2(v[2 * j] - pg8::bf_lo(ph), v[2 * j + 1] - pg8::bf_hi(ph)); }
        *(v4u*)(F.ws + WS_RTAB + (size_t)(ks * 64 + l) * 16) = oh; *(v4u*)(F.ws + WS_RTAB + 65536 + (size_t)(ks * 64 + l) * 16) = ol; }
    f32x4 wv[4];
#pragma unroll
    for (int j = 0; j < 4; ++j) wv[j] = *((const f32x4*)anw + lane + 64 * j);
    for (int m = gw; m < M; m += 2 * NGW) {
        const f32x4* xr0 = (const f32x4*)(x + (size_t)m * D) + lane; const f32x4* xr1 = (const f32x4*)(x + (size_t)(m + NGW) * D) + lane;
        f32x4 v0[4], v1[4]; float s0 = 0.f, s1 = 0.f;
#pragma unroll
        for (int j = 0; j < 4; ++j) { v0[j] = __builtin_nontemporal_load(xr0 + 64 * j); v1[j] = __builtin_nontemporal_load(xr1 + 64 * j); }
#pragma unroll
        for (int j = 0; j < 4; ++j) { s0 += (v0[j].x * v0[j].x + v0[j].y * v0[j].y) + (v0[j].z * v0[j].z + v0[j].w * v0[j].w); s1 += (v1[j].x * v1[j].x + v1[j].y * v1[j].y) + (v1[j].z * v1[j].z + v1[j].w * v1[j].w); }
        const float r0 = rsqrtf(wave_sum(s0) * (1.f / D) + NORM_EPS), r1 = rsqrtf(wave_sum(s1) * (1.f / D) + NORM_EPS);
        unsigned long long* o0 = (unsigned long long*)(XN + (size_t)m * D) + lane; unsigned long long* o1 = (unsigned long long*)(XN + (size_t)(m + NGW) * D) + lane;
        unsigned* q0 = (unsigned*)(F.ws + WS_XN8 + (size_t)m * D) + lane; unsigned* q1 = (unsigned*)(F.ws + WS_XN8 + (size_t)(m + NGW) * D) + lane;
#pragma unroll
        for (int j = 0; j < 4; ++j) { const f32x4 y0 = v0[j] * r0 * wv[j], y1 = v1[j] * r1 * wv[j];
            o0[64 * j] = (unsigned long long)pk2(y0.x, y0.y) | ((unsigned long long)pk2(y0.z, y0.w) << 32); o1[64 * j] = (unsigned long long)pk2(y1.x, y1.y) | ((unsigned long long)pk2(y1.z, y1.w) << 32);
            q0[64 * j] = pg8::pk4_fp8(y0.x, y0.y, y0.z, y0.w); q1[64 * j] = pg8::pk4_fp8(y1.x, y1.y, y1.z, y1.w); }
    }
}

__device__ __forceinline__ int crow16(int r, int hi) { return (r & 3) + 8 * (r >> 2) + 4 * hi; }
#define RT_BETTER(xv, xi, yv, yi) ((xv) > (yv) || ((xv) == (yv) && (xi) < (yi)))
#define RT_CSWAP(va, ia, vb, ib) do { if (RT_BETTER(vb, ib, va, ia)) { const float tv_ = va; va = vb; vb = tv_; const int ti_ = ia; ia = ib; ib = ti_; } } while (0)
__device__ __forceinline__ void p5_route(Frame& F, const float* x, const float* fnw, const float* rb, const float* wd, bool dummy = false) {
    LAS float* wnl = (LAS float*)(F.lds + 140288);
    LAS int* lcnt = (LAS int*)(F.lds + 144384);
    LAS int* lbase = lcnt + 32;
    LAS float* part = (LAS float*)(F.lds);
    unsigned char* HNU = F.ws + WS_XN;
    int* laid = (int*)(F.ws + (dummy ? WS_YBUF : WS_LAID)); float* lrs = (float*)(F.ws + (dummy ? WS_YBUF + 4 * MiB : WS_LRS)); float* lgate = (float*)(F.ws + (dummy ? WS_YBUF + 8 * MiB : WS_LGATE));
    unsigned* gcnt = (unsigned*)(F.ctl + (dummy ? 16384 : CW_CNT));
    const int lane = pg8::lane_now(), wave = F.wave, tid = wave * 64 + lane, r32 = lane & 31, hi = lane >> 5;
    typedef unsigned u32x2_t __attribute__((ext_vector_type(2)));
    const __amdgpu_buffer_rsrc_t rsx = __builtin_amdgcn_make_buffer_rsrc((void*)x, 0, 0x7fffffff, 0x00020000);
    const __amdgpu_buffer_rsrc_t rsw = __builtin_amdgcn_make_buffer_rsrc((void*)F.ws, 0, 0x7fffffff, 0x00020000);
    LAS unsigned char* wb = F.lds + wave * 16384;
    bf16x8 whi[8], wlo[8];
#pragma unroll
    for (int q = 0; q < 8; ++q) { const size_t e = ((size_t)(8 * wave + q) * 64 + lane) * 16; whi[q] = *(const bf16x8*)(F.ws + WS_RTAB + e); wlo[q] = *(const bf16x8*)(F.ws + WS_RTAB + 65536 + e); }
#pragma clang loop vectorize(disable) unroll(disable)
    for (int idx = tid; idx < 1024; idx += NWAVES * 64) wnl[idx] = fnw[idx];
    unsigned vx[4];
#pragma unroll
    for (int i = 0; i < 4; ++i) { const int row = 8 * i + (lane >> 3); vx[i] = (unsigned)(row * 4096 + 16 * ((lane & 7) ^ ((row >> 1) & 7))); }
    const unsigned va = (unsigned)((lane >> 2) * 2048 + 16 * ((lane & 3) ^ ((lane >> 4) & 3)));
    const int fx = (r32 >> 1) & 7, fa = (r32 >> 2) & 3;
    int witem = F.vcu * NWAVES + wave;
    for (int tb = F.vcu; tb < M / 128; tb += F.G) {
        const int tok0 = tb * 128;
        if (tid < 32) lcnt[tid] = 0;
        f32x16 acc[4]; float ss[4];
#pragma unroll
        for (int g = 0; g < 4; ++g) { acc[g] = (f32x16){}; ss[g] = 0.f; }
#define P5_DMA(s_) do { const int g_ = (s_) >> 2, st_ = (s_) & 3; LAS unsigned char* b_ = wb + ((s_) & 1) * 6144; \
            const unsigned sx_ = (unsigned)(tok0 + 32 * g_) * 4096u + (unsigned)(128 * wave + 32 * st_) * 4u, sa_ = (unsigned)WS_YA + (unsigned)(tok0 + 32 * g_) * 2048u + (unsigned)(128 * wave + 32 * st_) * 2u; \
            _Pragma("unroll") for (int i = 0; i < 4; ++i) __builtin_amdgcn_raw_ptr_buffer_load_lds(rsx, (LAS unsigned*)(b_ + i * 1024), 16, (int)vx[i], (int)sx_, 0, 0); \
            _Pragma("unroll") for (int i = 0; i < 2; ++i) __builtin_amdgcn_raw_ptr_buffer_load_lds(rsw, (LAS unsigned*)(b_ + 4096 + i * 1024), 16, (int)va, (int)(sa_ + (unsigned)(i * 16 * 2048)), 0, 0); } while (0)
        asm volatile("s_waitcnt lgkmcnt(0)" ::: "memory"); __syncthreads();
        P5_DMA(0);
#pragma clang loop unroll(full)
        for (int s = 0; s < 16; ++s) {
            const int g = s >> 2, st = s & 3;
            LAS unsigned char* bs = wb + (s & 1) * 6144; LAS unsigned char* hs = wb + 12288;
            if (s < 15) { asm volatile("s_waitcnt lgkmcnt(0)" ::: "memory"); P5_DMA(s + 1); asm volatile("s_waitcnt vmcnt(6)" ::: "memory"); }
            else asm volatile("s_waitcnt vmcnt(0)" ::: "memory");
#pragma unroll
            for (int q = 0; q < 2; ++q) {
                f32x4 a = *(const LAS f32x4*)(bs + r32 * 128 + 16 * ((4 * q + 2 * hi) ^ fx)), b = *(const LAS f32x4*)(bs + r32 * 128 + 16 * ((4 * q + 2 * hi + 1) ^ fx));
                const v4u t_ = *(const LAS v4u*)(bs + 4096 + r32 * 64 + 16 * ((2 * q + hi) ^ fa));
                a.x += pg8::bf_lo(t_.x); a.y += pg8::bf_hi(t_.x); a.z += pg8::bf_lo(t_.y); a.w += pg8::bf_hi(t_.y); b.x += pg8::bf_lo(t_.z); b.y += pg8::bf_hi(t_.z); b.z += pg8::bf_lo(t_.w); b.w += pg8::bf_hi(t_.w);
                ss[g] += (a.x * a.x + a.y * a.y) + (a.z * a.z + a.w * a.w) + (b.x * b.x + b.y * b.y) + (b.z * b.z + b.w * b.w);
                v4u ph, pl;
                ph.x = pk2(a.x, a.y); ph.y = pk2(a.z, a.w); ph.z = pk2(b.x, b.y); ph.w = pk2(b.z, b.w);
                pl.x = pk2(a.x - pg8::bf_lo(ph.x), a.y - pg8::bf_hi(ph.x)); pl.y = pk2(a.z - pg8::bf_lo(ph.y), a.w - pg8::bf_hi(ph.y));
                pl.z = pk2(b.x - pg8::bf_lo(ph.z), b.y - pg8::bf_hi(ph.z)); pl.w = pk2(b.z - pg8::bf_lo(ph.w), b.w - pg8::bf_hi(ph.w));
                const bf16x8 hh = __builtin_bit_cast(bf16x8, ph), hl = __builtin_bit_cast(bf16x8, pl);
                acc[g] = __builtin_amdgcn_mfma_f32_32x32x16_bf16(whi[2 * st + q], hh, acc[g], 0, 0, 0);
                acc[g] = __builtin_amdgcn_mfma_f32_32x32x16_bf16(whi[2 * st + q], hl, acc[g], 0, 0, 0);
                acc[g] = __builtin_amdgcn_mfma_f32_32x32x16_bf16(wlo[2 * st + q], hh, acc[g], 0, 0, 0);
                const int kk = 128 * wave + 32 * st + 16 * q + 8 * hi;
                const f32x4 w0 = *(const LAS f32x4*)(wnl + kk), w1 = *(const LAS f32x4*)(wnl + kk + 4);
                u32x2_t o; o.x = pg8::pk4_fp8(a.x * w0.x, a.y * w0.y, a.z * w0.z, a.w * w0.w); o.y = pg8::pk4_fp8(b.x * w1.x, b.y * w1.y, b.z * w1.z, b.w * w1.w);
                *(LAS u32x2_t*)(hs + r32 * 128 + 16 * (2 * st + q) + 8 * hi) = o;
            }
            if (st == 3) {
                asm volatile("" ::: "memory");
#pragma unroll
                for (int i = 0; i < 4; ++i) { const int row = 8 * i + (lane >> 3); const v4u v = *(const LAS v4u*)(hs + row * 128 + 16 * (lane & 7));
                    *(v4u*)(HNU + (size_t)(tok0 + 32 * g + row) * D + 128 * wave + 16 * (lane & 7)) = v; }
                asm volatile("" ::: "memory");
            }
            __builtin_amdgcn_sched_barrier(0);
        }
#undef P5_DMA
        asm volatile("s_waitcnt vmcnt(0) lgkmcnt(0)" ::: "memory"); __syncthreads();
        {
        const int lane = pg8::lane_now(), tid = wave * 64 + lane, r32 = lane & 31, hi = lane >> 5;
#pragma unroll
        for (int g = 0; g < 4; ++g) {
#pragma unroll
            for (int r = 0; r < 16; ++r) part[((wave * 4 + g) * 17 + r) * 64 + lane] = acc[g][r];
            part[((wave * 4 + g) * 17 + 16) * 64 + lane] = ss[g]; }
        __syncthreads();
        int te[4] = {0, 0, 0, 0}, rk[4] = {0, 0, 0, 0}; float tg[4] = {0.f, 0.f, 0.f, 0.f}; float rstd = 0.f;
        const int token = tok0 + 32 * wave + r32;
        if (wave < 4) {
            f32x16 lg = {}; float sq = 0.f;
#pragma unroll
            for (int w = 0; w < 8; ++w) {
#pragma unroll
                for (int r = 0; r < 16; ++r) lg[r] += part[((w * 4 + wave) * 17 + r) * 64 + lane];
                sq += part[((w * 4 + wave) * 17 + 16) * 64 + lane]; }
            sq += __shfl_xor(sq, 32);
            rstd = rsqrtf(sq * (1.f / D) + NORM_EPS);
            float v0 = -INFINITY, v1 = -INFINITY, v2 = -INFINITY, v3 = -INFINITY; int i0 = 99, i1 = 99, i2 = 99, i3 = 99;
#pragma unroll
            for (int r = 0; r < 16; ++r) { const int e = crow16(r, hi); float v4 = lg[r] * rstd + rb[e]; int i4 = e;
                RT_CSWAP(v3, i3, v4, i4); RT_CSWAP(v2, i2, v3, i3); RT_CSWAP(v1, i1, v2, i2); RT_CSWAP(v0, i0, v1, i1); }
            float ov[4] = {__shfl_xor(v0, 32), __shfl_xor(v1, 32), __shfl_xor(v2, 32), __shfl_xor(v3, 32)};
            int oi[4] = {__shfl_xor(i0, 32), __shfl_xor(i1, 32), __shfl_xor(i2, 32), __shfl_xor(i3, 32)};
#pragma unroll
            for (int q = 0; q < 4; ++q) { float v4 = ov[q]; int i4 = oi[q];
                RT_CSWAP(v3, i3, v4, i4); RT_CSWAP(v2, i2, v3, i3); RT_CSWAP(v1, i1, v2, i2); RT_CSWAP(v0, i0, v1, i1); }
            const float p1 = __expf(v1 - v0), p2 = __expf(v2 - v0), p3 = __expf(v3 - v0), inv = 1.0f / (1.0f + p1 + p2 + p3);
            te[0] = i0; te[1] = i1; te[2] = i2; te[3] = i3; tg[0] = inv; tg[1] = p1 * inv; tg[2] = p2 * inv; tg[3] = p3 * inv;
            if (hi == 0) {
#pragma unroll
                for (int q = 0; q < 4; ++q) rk[q] = atomicAdd((int*)&lcnt[te[q]], 1);
            }
        }
        __syncthreads();
        if (tid < 32) lbase[tid] = (int)atomicAdd(&gcnt[tid * 64], (unsigned)lcnt[tid]);
        __syncthreads();
        if (wave < 4 && hi == 0) {
#pragma unroll
            for (int q = 0; q < 4; ++q) { const size_t pos = (size_t)te[q] * ECAP + lbase[te[q]] + rk[q];
                laid[pos] = token * 4 + q; lrs[pos] = rstd; lgate[pos] = tg[q]; }
            if (!dummy) *(f32x4*)((float*)(F.ws + WS_TG) + (size_t)token * 4) = (f32x4){tg[0], tg[1], tg[2], tg[3]};
        }
        __syncthreads();
        }
    }
    (void)wd; (void)witem;
}

__device__ __forceinline__ int moe_tables(Frame& F) {
    LAS int* tiletab = (LAS int*)(F.lds + TILETAB_OFF); LAS int* cnt = (LAS int*)(F.lds + CNT_OFF); LAS int* tpre = cnt + 32;
    const int tid = F.wave * 64 + pg8::lane_now();
    if (F.wave == 0) {
        const int ln = pg8::lane_now(); int c_ = 0;
        if (ln < 32) c_ = (int)__hip_atomic_load(F.ctl + CW_CNT + ln * 64, RLX_AGENT);
        int inc = (ln < 32) ? ((c_ + 255) >> 8) : 0;
#pragma unroll
        for (int o = 1; o < 32; o <<= 1) { const int v_ = __shfl_up(inc, o); if (ln >= o) inc += v_; }
        if (ln < 32) { cnt[ln] = c_; tpre[ln] = inc - ((c_ + 255) >> 8); if (ln == 31) tpre[NE] = inc; }
    }
    __syncthreads();
    const int nM = tpre[NE];
    for (int t = tid; t < nM; t += NWAVES * 64) {
        int lo_ = 0, hi_ = NE - 1;
#pragma unroll
        for (int it = 0; it < 5; ++it) { const int mid = (lo_ + hi_ + 1) >> 1; if (tpre[mid] <= t) lo_ = mid; else hi_ = mid - 1; }
        tiletab[t] = (lo_ << 16) | (t - tpre[lo_]); }
    __syncthreads();
    return nM;
}

__device__ __forceinline__ void p8_combine(Frame& F, const float* x, float* dst) {
    typedef float f32x2 __attribute__((ext_vector_type(2)));
    const int gw = F.vcu * NWAVES + F.wave, NGW = F.G * NWAVES, lane = pg8::lane_now();
    const unsigned char* Y = F.ws + WS_YBUF;
    for (int m0 = gw; m0 < M; m0 += 2 * NGW) {
        f32x4 v[2][4]; unsigned w[2][4][4]; unsigned long long at[2][4]; f32x4 gq[2];
#pragma unroll
        for (int t = 0; t < 2; ++t) gq[t] = *(const f32x4*)((const float*)(F.ws + WS_TG) + (size_t)(m0 + t * NGW) * 4);
#pragma unroll
        for (int t = 0; t < 2; ++t) { const int m = m0 + t * NGW; const f32x4* orow = (const f32x4*)(x + (size_t)m * D) + lane;
            const unsigned long long* ar = (const unsigned long long*)((const bf16*)(F.ws + WS_YA) + (size_t)m * D) + lane;
#pragma unroll
            for (int j = 0; j < 4; ++j) { v[t][j] = __builtin_nontemporal_load(orow + 64 * j); at[t][j] = __builtin_nontemporal_load(ar + 64 * j); }
#pragma unroll
            for (int q = 0; q < 4; ++q) { const unsigned* yr = (const unsigned*)(Y + (size_t)(m * 4 + q) * D) + lane;
#pragma unroll
                for (int j = 0; j < 4; ++j) w[t][q][j] = __builtin_nontemporal_load(yr + 64 * j); } }
#pragma unroll
        for (int t = 0; t < 2; ++t) { const int m = m0 + t * NGW; f32x4* orow = (f32x4*)(dst + (size_t)m * D) + lane;
#pragma unroll
            for (int j = 0; j < 4; ++j) { { const unsigned lo_ = (unsigned)at[t][j], hi_ = (unsigned)(at[t][j] >> 32); v[t][j].x += pg8::bf_lo(lo_); v[t][j].y += pg8::bf_hi(lo_); v[t][j].z += pg8::bf_lo(hi_); v[t][j].w += pg8::bf_hi(hi_); }
#pragma unroll
                for (int q = 0; q < 4; ++q) { const f32x2 a = __builtin_amdgcn_cvt_pk_f32_fp8((int)w[t][q][j], false), b = __builtin_amdgcn_cvt_pk_f32_fp8((int)w[t][q][j], true);
                    const float g_ = gq[t][q]; v[t][j].x = __builtin_fmaf(a.x, g_, v[t][j].x); v[t][j].y = __builtin_fmaf(a.y, g_, v[t][j].y); v[t][j].z = __builtin_fmaf(b.x, g_, v[t][j].z); v[t][j].w = __builtin_fmaf(b.y, g_, v[t][j].w); }
                __builtin_nontemporal_store(v[t][j], orow + 64 * j); } }
    }
}
struct Args { const float* in[16]; float* out; unsigned char* ws; int ph_lo, ph_hi, li, pad; };
__global__ void __launch_bounds__(NWAVES * 64, 2) moe_block_fwd(Args args) {
    extern __shared__ __attribute__((aligned(16))) unsigned char lds[];
    Frame F;
    F.lds = (LAS unsigned char*)lds;
    F.MISC = (volatile LAS unsigned*)(F.lds + MISC_OFF);
    F.wave = __builtin_amdgcn_readfirstlane((int)threadIdx.x >> 6);
    F.G = gridDim.x; { const int bx = blockIdx.x; F.vcu = (F.G % 8 == 0) ? (bx % 8) * (F.G / 8) + bx / 8 : bx; }
    F.ws = args.ws; F.ctl = (gu32*)(args.ws + WS_CTL); F.out = args.out;
    for (int u = F.wave * 64 + pg8::lane_now(); u < (LDS_BYTES - LDSCTL_OFF) / 4; u += NWAVES * 64) ((LAS unsigned*)(F.lds + LDSCTL_OFF))[u] = 0u;
    __syncthreads();
    XcdBarrier bar; bar.bar = (unsigned*)(F.ctl + CW_BAR); bar.x = 0; bar.st = nullptr;
    if (N_LAUNCHES != PER_PHASE) bar = xcd_barrier_post((unsigned*)(F.ctl + CW_BAR), F.MISC + 8, F.wave == 0 && pg8::lane_now() == 0);
#define GRID_BAR(seam) do { if (N_LAUNCHES == PER_PHASE) { if (F.wave == 0 && pg8::lane_now() == 0) __hip_atomic_store(F.ctl + CW_TMO, 0xBADBA0u | (unsigned)(seam), RLX_AGENT); } else { xcd_barrier(bar, F.wave == 0 && pg8::lane_now() == 0); } } while (0)
    const int lo = args.ph_lo, hi = args.ph_hi;
#define IN(k) (lo <= (k) && (k) < hi)
#define BOTH(k) (IN(k) && IN((k) + 1))
#define SPLIT67 (N_LAUNCHES != PER_PHASE && BOTH(6) && PROBE_REP != 7 && PROBE_REP != 6)
#define WIN ((bf16*)(F.ws + WS_WIN))
#define PA ((bf16*)(F.ws + WS_PA))
#define WO ((bf16*)(F.ws + WS_WO))
#define WGU ((bf16*)(F.ws + WS_WGU))
#define WD ((bf16*)(F.ws + WS_WD))
#define XN ((bf16*)(F.ws + WS_XN))
#define YA ((bf16*)(F.ws + WS_YA))
#define YB YA
#define MG ((bf16*)(F.ws + WS_MG))
#define PROJ ((bf16*)(F.ws + WS_PROJ))
#define ACT PROJ
#define YBUF ((bf16*)(F.ws + WS_YBUF))
    const LAS int* tiletab = (const LAS int*)(F.lds + TILETAB_OFF); const LAS int* cntl = (const LAS int*)(F.lds + CNT_OFF);
    LAS unsigned* rowtab = (LAS unsigned*)(F.lds + ROWTAB_OFF);

#ifndef PROBE_REP
#define PROBE_REP -1
#endif
#define REPS(k) ((PROBE_REP == (k)) ? 2 : 1)
    if (IN(0)) { for (int rep = 0; rep < REPS(0); ++rep) p0_prologue(F, args.in[0], args.in[1], args.in[2], args.in[6], args.in[7], args.in[8], args.in[12], args.in[14], args.in[9], args.in[10]); if (BOTH(0)) GRID_BAR(0); }
    if (IN(1)) for (int rep = 0; rep < REPS(1); ++rep) {
        { pg8::Gemm g{F.ws, (unsigned)WS_XN, (unsigned)WS_WIN, D, D}; pg8::StaticOrder S; S.init(M, GA_COL, F.G, (int)blockIdx.x);
          pg8::EpiBf16 E{PROJ, INW, 1.0f, 0};
          pg8::GuRider R{args.in[12], F.ws + WS_WGU, 0};
        S.fill((LAS int*)(F.lds + UCACHE_OFF), pg8::lane_now(), F.wave == 0); __syncthreads();
          pg8::gemm_phase<pg8::EpiBf16, pg8::StaticOrder, true, false, false, pg8::NoHook, pg8::GuRider>(F.lds + RING_OFF, g, S, E, F.wave, pg8::NoHook(), R); }
        { pg8::Gemm g{F.ws, (unsigned)WS_XN8, (unsigned)WS_WIN8, D / 2, D / 2}; pg8::StaticOrder S;
          if (F.G == 256) { const int bx = (int)blockIdx.x; if (bx < 128) S.init_uneven(M, INW - GA_COL, 128, bx, 640, 3); else S.init_uneven(M, INW - GA_COL, 128, bx - 128, 0, 5); }
          else S.init(M, INW - GA_COL, F.G, (int)blockIdx.x);
          pg8::EpiBf16 E{PROJ + GA_COL, INW, 0.03125f, 1};
          pg8::GuRider R{args.in[12], F.ws + WS_WGU, 1152};
        S.fill((LAS int*)(F.lds + UCACHE_OFF), pg8::lane_now(), F.wave == 0); __syncthreads();
          pg8::gemm_phase<pg8::EpiBf16, pg8::StaticOrder, true, false, true, pg8::NoHook, pg8::GuRider>(F.lds + RING_OFF, g, S, E, F.wave, pg8::NoHook(), R); }
        if (BOTH(1) && rep == REPS(1) - 1) GRID_BAR(1);
    }
    if (IN(2)) for (int rep = 0; rep < REPS(2); ++rep) {
        __syncthreads();
        if (F.wave == 0 && pg8::lane_now() == 0) F.MISC[16] = 0u;
        __syncthreads();
        att::attn_phase((__attribute__((address_space(3))) char*)(F.lds + RING_OFF), PROJ, YA, YB, args.in[3], args.in[4], args.in[5], args.in[12], F.ws + WS_WGU, F.ws, (unsigned)WS_PROJ, F.vcu, F.G, F.wave, pg8::lane_now(),
                        (__attribute__((address_space(3))) unsigned*)(F.lds + MISC_OFF + 64));
        if (BOTH(2) && rep == REPS(2) - 1) GRID_BAR(2);
    }
    if (IN(3)) for (int rep = 0; rep < REPS(3); ++rep) {
        pg8::Gemm g{F.ws, (unsigned)WS_YA, (unsigned)WS_PA, D, D}; pg8::StaticOrder S; S.init(M, D, F.G, (int)blockIdx.x);
        pg8::HookGateRatio H{PROJ + GA_COL, PROJ + GB_COL, INW};
        pg8::EpiGateFinal E{MG, D, PROJ + GB_COL, INW};
        S.fill((LAS int*)(F.lds + UCACHE_OFF), pg8::lane_now(), F.wave == 0); __syncthreads();
        pg8::gemm_phase<pg8::EpiGateFinal, pg8::StaticOrder, true, false, false, pg8::HookGateRatio>(F.lds + RING_OFF, g, S, E, F.wave, H);
        if (BOTH(3) && rep == REPS(3) - 1) GRID_BAR(3);
    }
    if (IN(4)) for (int rep = 0; rep < REPS(4); ++rep) {
        pg8::Gemm g{F.ws, (unsigned)WS_MG, (unsigned)WS_WO, D, D}; pg8::StaticOrder S; S.init(M, D, F.G, (int)blockIdx.x);
        pg8::EpiBf16D E{YA, D};
        S.fill((LAS int*)(F.lds + UCACHE_OFF), pg8::lane_now(), F.wave == 0); __syncthreads();
        pg8::gemm_phase<pg8::EpiBf16D, pg8::StaticOrder, true, false>(F.lds + RING_OFF, g, S, E, F.wave);
        if (BOTH(4) && rep == REPS(4) - 1) GRID_BAR(4);
    }
    if (IN(5)) { if (REPS(5) == 2) p5_route(F, args.in[0], args.in[9], args.in[11], args.in[14], true); p5_route(F, args.in[0], args.in[9], args.in[11], args.in[14]); if (BOTH(5)) GRID_BAR(5); }
    if (IN(6)) for (int rep = 0; rep < REPS(6); ++rep) {
        const int nM = moe_tables(F);
        pg8::GroupOrder S; S.init(nM, 2048 / 256, F.G, (int)blockIdx.x); S.tiletab = tiletab; S.rowtab = rowtab; S.bstride = 2048u * 1024u; S.gather = true;
        { const int* laid = (const int*)(F.ws + WS_LAID); pg8::Unit u;
          const int ln = pg8::lane_now();
          for (int i = F.wave; i < 18 && S.next(i, u); i += 8) { const int tt = tiletab[u.pm], e = tt >> 16, lr0 = (tt & 0xffff) * 256 + ln, ce = cntl[e]; int aid[4];
#pragma unroll
              for (int k = 0; k < 4; ++k) { const int lrow = lr0 + 64 * k; aid[k] = laid[(size_t)e * ECAP + (lrow < ce ? lrow : 0)]; }
#pragma unroll
              for (int k = 0; k < 4; ++k) rowtab[i * 256 + 64 * k + ln] = (unsigned)(aid[k] >> 2) * 1024u; }
          __syncthreads(); }
        pg8::Gemm g{F.ws, (unsigned)WS_XN, (unsigned)WS_WGU, D / 2, D / 2};
        pg8::EpiSwiglu E{(unsigned char*)ACT, args.in[13], (const float*)(F.ws + WS_LRS), tiletab, cntl};
        if (SPLIT67 && rep == REPS(6) - 1) {
            const int RF = S.nwg / F.G, nl = S.nwg - RF * F.G, tid = F.wave * 64 + pg8::lane_now();
            LAS unsigned char* late = (LAS unsigned char*)(F.lds + LATE_OFF);
            for (int t = tid; t < 576; t += NWAVES * 64) late[t] = 0;
            __syncthreads();
            if (tid < nl) { pg8::GroupOrder T = S; T.cache = nullptr; T.c = tid; pg8::Unit u; if (T.next(RF, u)) late[u.pm] = 1; }
            __syncthreads();
            const bool tid0 = (tid == 0); const unsigned nloc = F.MISC[8], nx = F.MISC[9];
            S.fill((LAS int*)(F.lds + UCACHE_OFF), pg8::lane_now(), F.wave == 0); __syncthreads();
            S.ibase = 0; S.nmine = RF;
            pg8::WdRider R{args.in[14], F.ws + WS_WD, 0};
            pg8::gemm_phase<pg8::EpiSwiglu, pg8::GroupOrder, true, true, true, pg8::NoHook, pg8::WdRider>(F.lds + RING_OFF, g, S, E, F.wave, pg8::NoHook(), R);
            asm volatile("s_waitcnt vmcnt(0)" ::: "memory"); __syncthreads();
            seam_arrive((unsigned*)(F.ctl + CW_SEAM1), bar.x, nloc, tid0);
            S.ibase = RF; S.nmine = 1;
            pg8::gemm_phase<pg8::EpiSwiglu, pg8::GroupOrder, true, true, true>(F.lds + RING_OFF, g, S, E, F.wave);
            asm volatile("s_waitcnt vmcnt(0)" ::: "memory"); __syncthreads();
            seam_arrive((unsigned*)(F.ctl + CW_SEAM2), bar.x, nloc, tid0);
            (void)nx;
        } else {
            pg8::WdRider R{args.in[14], F.ws + WS_WD, 0};
            pg8::gemm_phase<pg8::EpiSwiglu, pg8::GroupOrder, true, true, true, pg8::NoHook, pg8::WdRider>(F.lds + RING_OFF, g, S, E, F.wave, pg8::NoHook(), R);
            if (BOTH(6) && rep == REPS(6) - 1) GRID_BAR(6);
        }
    }
    if (IN(7)) for (int rep = 0; rep < REPS(7); ++rep) {
        const int nM = (SPLIT67 && rep == 0) ? ((const LAS int*)(F.lds + CNT_OFF))[32 + NE] : moe_tables(F);
        pg8::Gemm g{F.ws, (unsigned)WS_PROJ, (unsigned)WS_WD, DFF / 2, DFF / 2};
        pg8::EpiDown E{(unsigned char*)YBUF, args.in[15], (const int*)(F.ws + WS_LAID), (const float*)(F.ws + WS_LGATE), tiletab, cntl};
        if (SPLIT67 && rep == 0) {
            const int bx = (int)blockIdx.x, c7 = (F.G == 256) ? ((bx & 7) | ((31 - (bx >> 3)) << 3)) : bx;
            pg8::GroupOrder S; S.init(nM, 1024 / 256, F.G, c7); S.tiletab = tiletab; S.rowtab = nullptr; S.bstride = 1024u * 1024u; S.gather = false;
            LAS int* ulist = (LAS int*)(F.lds + ULIST_OFF); const LAS unsigned char* late = (const LAS unsigned char*)(F.lds + LATE_OFF);
            if (F.wave == 0) {
                const int ln = pg8::lane_now(); pg8::Unit u; int code = -1;
                if (ln < 14 && S.next(ln, u)) code = (u.pm << 4) | u.pn | (late[u.pm] ? (1 << 30) : 0);
                const bool isA = code >= 0 && !(code >> 30), isB = code >= 0 && (code >> 30);
                const unsigned long long mA = __ballot(isA), mB = __ballot(isB), below = (1ull << ln) - 1ull;
                const int nA = __popcll(mA), nB = __popcll(mB);
                if (isA) ulist[__popcll(mA & below)] = code;
                if (isB) ulist[nA + __popcll(mB & below)] = code & ~(1 << 30);
                if (ln == 0) { ulist[30] = nA + nB; ulist[31] = nA; } }
            __syncthreads();
            pg8::ListOrder L; L.list = ulist; L.n = ulist[30]; L.nA = ulist[31]; L.tiletab = tiletab; L.bstride = 1024u * 1024u; L.flag2 = (unsigned*)(F.ctl + CW_SEAM2) + SB_TOP; L.nx2 = F.MISC[9];
            seam_wait((unsigned*)(F.ctl + CW_SEAM1), F.MISC[9], (unsigned*)(F.ctl + CW_BAR), F.wave == 0 && pg8::lane_now() == 0);
            pg8::gemm_phase<pg8::EpiDown, pg8::ListOrder, true, false, true, pg8::NoHook, pg8::NoRider, true>(F.lds + RING_OFF, g, L, E, F.wave);
        } else {
            pg8::GroupOrder S; S.init(nM, 1024 / 256, F.G, (int)blockIdx.x); S.tiletab = tiletab; S.rowtab = nullptr; S.bstride = 1024u * 1024u; S.gather = false;
            pg8::gemm_phase<pg8::EpiDown, pg8::GroupOrder, true, false, true, pg8::NoHook, pg8::NoRider, true>(F.lds + RING_OFF, g, S, E, F.wave);
        }
        if (BOTH(7) && rep == REPS(7) - 1) GRID_BAR(7);
    }
    if (IN(8)) { if (REPS(8) == 2) p8_combine(F, args.in[0], (float*)(F.ws + WS_MG)); p8_combine(F, args.in[0], F.out); }
#undef IN
#undef BOTH
}

extern "C" void kernel_launch(void* const* d_in, const int* in_sizes, int n_in, void* d_out, int out_size, void* d_ws, size_t ws_size, hipStream_t stream) {
    static int grid = 0;
    if (grid == 0) {
        if (n_in != 16 || in_sizes[0] != M * D || out_size != M * D || ws_size < WS_END) { fprintf(stderr, "kernel_launch: unexpected shapes (n_in %d, in0 %d, out %d, ws %zu); nothing launched\n", n_in, n_in > 0 ? in_sizes[0] : -1, out_size, ws_size); grid = -1; return; }
        int dev = 0, cus = 0, per_cu = 0;
        if (hipGetDevice(&dev) != hipSuccess || hipDeviceGetAttribute(&cus, hipDeviceAttributeMultiprocessorCount, dev) != hipSuccess) { fprintf(stderr, "kernel_launch: device query failed\n"); grid = -1; return; }
        if (hipFuncSetAttribute((const void*)moe_block_fwd, hipFuncAttributeMaxDynamicSharedMemorySize, LDS_BYTES) != hipSuccess) { fprintf(stderr, "kernel_launch: hipFuncSetAttribute failed\n"); grid = -1; return; }
        if (hipOccupancyMaxActiveBlocksPerMultiprocessor(&per_cu, (const void*)moe_block_fwd, NWAVES * 64, LDS_BYTES) != hipSuccess || per_cu < 1)
            fprintf(stderr, "kernel_launch: note: occupancy query reports %d workgroups per CU\n", per_cu);
        (void)hipGetLastError();
        grid = cus;
        if (grid < 160 || grid > 1024) { fprintf(stderr, "kernel_launch: unsupported CU count %d\n", grid); grid = -1; return; }
    }
    if (grid < 0) return;
    if (hipMemsetAsync((char*)d_ws + WS_CTL, 0, CTL_ZERO_BYTES, stream) != hipSuccess) { fprintf(stderr, "kernel_launch: memset failed\n"); return; }
    Args a{};
    for (int i = 0; i < 16; ++i) a.in[i] = (const float*)d_in[i];
    a.out = (float*)d_out; a.ws = (unsigned char*)d_ws;
    for (int li = 0; li < N_LAUNCHES; ++li) {
        a.ph_lo = (N_LAUNCHES == PER_PHASE) ? li : 0; a.ph_hi = (N_LAUNCHES == PER_PHASE) ? li + 1 : PER_PHASE; a.li = li;
        hipLaunchKernelGGL(moe_block_fwd, dim3(grid), dim3(NWAVES * 64), LDS_BYTES, stream, a);
        const hipError_t le = hipPeekAtLastError();
        if (le != hipSuccess) { fprintf(stderr, "kernel_launch: launch %d failed: %s\n", li, hipGetErrorName(le)); break; }
    }
}
```
